# Optimizing an MI355X kernel written in HIP

```python
import math
import jax, jax.numpy as jnp
from jax import lax
import numpy as np

D_MODEL = 2048
BATCH = 16
SEQ = 2048
DEPTH = 4

CTX_LEN = 256
GRID_W = 64
QBLK = 128
ROPE_BASE = 10000.0
EPS = 1e-6

DIFF_HEADS = 8
DIFF_HD = 64
DIFF_VD = 2 * DIFF_HD
DIFF_W = DIFF_HEADS * DIFF_VD
DIFF_SCALE = DIFF_HD ** -0.5

MLA_HEADS = 8
MLA_Q_RANK = 512
MLA_KV_RANK = 256
MLA_NOPE = 128
MLA_ROPE = 64
MLA_VD = 128
MLA_W = MLA_HEADS * MLA_VD
MLA_SCALE = (MLA_NOPE + MLA_ROPE) ** -0.5

ROPE_DIM = 64
AXIS_DIM = ROPE_DIM // 2

D_FF = 4 * D_MODEL
N_BRANCH = 2
N_MOD = 6

IN_SPLITS = (
    DIFF_HEADS * 2 * DIFF_HD,
    DIFF_HEADS * 2 * DIFF_HD,
    DIFF_HEADS * DIFF_VD,
    MLA_Q_RANK,
    MLA_KV_RANK,
    MLA_ROPE,
    N_BRANCH * D_MODEL,
)
IN_W = sum(IN_SPLITS)

kernel_name = "hybrid_diffattn_mla_dit_trunk"


def rmsnorm(x, g):
    xf = x.astype(jnp.float32)
    y = xf * lax.rsqrt(jnp.mean(xf * xf, axis=-1, keepdims=True) + EPS)
    return (y * g.astype(jnp.float32)).astype(x.dtype)


def modulate(h, shift, scale):
    return h * (1 + scale) + shift


def axial_tables(n_tokens):
    rows = n_tokens // GRID_W
    row, col = jnp.meshgrid(jnp.arange(rows), jnp.arange(GRID_W), indexing="ij")
    row = row.reshape(-1).astype(jnp.float32)
    col = col.reshape(-1).astype(jnp.float32)
    freqs = ROPE_BASE ** (-jnp.arange(0, AXIS_DIM, 2, dtype=jnp.float32) / AXIS_DIM)
    ang_r = row[:, None] * freqs
    ang_c = col[:, None] * freqs
    ang = jnp.concatenate([ang_r, ang_r, ang_c, ang_c], axis=-1)
    return jnp.cos(ang), jnp.sin(ang)


def rotate_half_axial(x):
    h = AXIS_DIM // 2
    return jnp.concatenate([-x[..., h:AXIS_DIM], x[..., :h],
                            -x[..., AXIS_DIM + h:], x[..., AXIS_DIM:AXIS_DIM + h]], axis=-1)


def apply_rope(x, rope):
    cos, sin = rope
    xf = x.astype(jnp.float32)
    out = xf * cos[None, :, None, :] + rotate_half_axial(xf) * sin[None, :, None, :]
    return out.astype(x.dtype)


def sweep_query_blocks(fn, qs):
    b, t = qs[0].shape[:2]
    nb = t // QBLK
    blocks = tuple(jnp.moveaxis(q.reshape(b, nb, QBLK, *q.shape[2:]), 1, 0) for q in qs)
    out = lax.map(lambda blk: fn(*blk), blocks)
    out = jnp.moveaxis(out, 0, 1)
    return out.reshape(b, t, *out.shape[3:])


def diff_block(q1, q2, k1, k2, v, lam):
    s1 = jnp.einsum("bqhd,bkhd->bhqk", q1, k1).astype(jnp.float32) * DIFF_SCALE
    s2 = jnp.einsum("bqhd,bkhd->bhqk", q2, k2).astype(jnp.float32) * DIFF_SCALE
    a = jax.nn.softmax(s1, axis=-1) - lam * jax.nn.softmax(s2, axis=-1)
    return jnp.einsum("bhqk,bkhd->bqhd", a.astype(v.dtype), v)


def mla_block(q, k, v):
    s = jnp.einsum("bqhd,bkhd->bhqk", q, k).astype(jnp.float32) * MLA_SCALE
    p = jax.nn.softmax(s, axis=-1)
    return jnp.einsum("bhqk,bkhd->bqhd", p.astype(v.dtype), v)


def mixer_projections(h, w_in, b_gate, q_a_norm, w_uq, kv_a_norm, w_ukv, rope):
    b, t, _ = h.shape
    offsets = [int(o) for o in np.cumsum(IN_SPLITS)[:-1]]
    qd, kd, vd, cq, ckv, kr, gpre = jnp.split(h @ w_in, offsets, axis=-1)
    qd = qd.reshape(b, t, DIFF_HEADS, 2, DIFF_HD)
    kd = kd.reshape(b, t, DIFF_HEADS, 2, DIFF_HD)
    q1, q2 = qd[..., 0, :], qd[..., 1, :]
    k1, k2 = kd[..., 0, :], kd[..., 1, :]
    v_d = vd.reshape(b, t, DIFF_HEADS, DIFF_VD)
    qm = (rmsnorm(cq, q_a_norm) @ w_uq).reshape(b, t, MLA_HEADS, MLA_NOPE + MLA_ROPE)
    q_nope, q_pe = qm[..., :MLA_NOPE], qm[..., MLA_NOPE:]
    kv = (rmsnorm(ckv, kv_a_norm) @ w_ukv).reshape(b, t, MLA_HEADS, MLA_NOPE + MLA_VD)
    k_nope, v_m = kv[..., :MLA_NOPE], kv[..., MLA_NOPE:]
    k_pe = kr.reshape(b, t, 1, MLA_ROPE)
    if rope is not None:
        q1, q2, k1, k2 = (apply_rope(a, rope) for a in (q1, q2, k1, k2))
        q_pe = apply_rope(q_pe, rope)
        k_pe = apply_rope(k_pe, rope)
    q_m = jnp.concatenate([q_nope, q_pe], axis=-1)
    k_m = jnp.concatenate([k_nope, jnp.broadcast_to(k_pe, (b, t, MLA_HEADS, MLA_ROPE))], axis=-1)
    gates = jax.nn.sigmoid((gpre + b_gate).astype(jnp.float32)).astype(h.dtype)
    return (q1, q2, q_m), (k1, k2, v_d, k_m, v_m), gates


def mix(queries, keys, gates, lam, lam_init, diff_subln, w_o_diff, w_o_mla, w_out):
    q1, q2, q_m = queries
    k1, k2, v_d, k_m, v_m = keys
    b, t = q1.shape[:2]
    y_d = sweep_query_blocks(lambda a, c: diff_block(a, c, k1, k2, v_d, lam), (q1, q2))
    y_d = rmsnorm(y_d, diff_subln) * (1.0 - lam_init)
    y_m = sweep_query_blocks(lambda a: mla_block(a, k_m, v_m), (q_m,))
    y_d = y_d.reshape(b, t, DIFF_W) @ w_o_diff
    y_m = y_m.reshape(b, t, MLA_W) @ w_o_mla
    merged = gates[..., :D_MODEL] * y_d + gates[..., D_MODEL:] * y_m
    return merged @ w_out


def sq_relu_mlp(h, w1, w2):
    u = jax.nn.relu(h @ w1)
    return (u * u) @ w2


def setup_inputs(seed: int = 0) -> dict:
    key = jax.random.key(seed)
    ks = jax.random.split(key, 24)

    def nrm(k, shape, scale):
        return jax.random.normal(k, shape, jnp.float32) * scale

    def gain(k, shape):
        return 1.0 + 0.02 * jax.random.normal(k, shape, jnp.float32)

    L, D = DEPTH, D_MODEL
    return {
        "x": nrm(ks[0], (BATCH, SEQ, D), 1.0),
        "c": nrm(ks[1], (BATCH, D), 1.0),
        "ctx": nrm(ks[2], (BATCH, CTX_LEN, D), 1.0),
        "c_ctx": nrm(ks[3], (D,), 0.5),
        "w_ada": nrm(ks[4], (L, D, N_MOD * D), 0.5 * D ** -0.5),
        "b_ada": nrm(ks[5], (L, N_MOD * D), 0.01),
        "norm1_g": gain(ks[6], (L, D)),
        "norm2_g": gain(ks[7], (L, D)),
        "w_in": nrm(ks[8], (L, D, IN_W), D ** -0.5),
        "b_gate": nrm(ks[9], (L, N_BRANCH * D), 0.01),
        "q_a_norm": gain(ks[10], (L, MLA_Q_RANK)),
        "w_uq": nrm(ks[11], (L, MLA_Q_RANK, MLA_HEADS * (MLA_NOPE + MLA_ROPE)), MLA_Q_RANK ** -0.5),
        "kv_a_norm": gain(ks[12], (L, MLA_KV_RANK)),
        "w_ukv": nrm(ks[13], (L, MLA_KV_RANK, MLA_HEADS * (MLA_NOPE + MLA_VD)), MLA_KV_RANK ** -0.5),
        "diff_lambda": nrm(ks[14], (L, 4, DIFF_HD), 0.1),
        "diff_subln": gain(ks[15], (L, DIFF_VD)),
        "w_o_diff": nrm(ks[16], (L, DIFF_W, D), DIFF_W ** -0.5),
        "w_o_mla": nrm(ks[17], (L, MLA_W, D), MLA_W ** -0.5),
        "w_out": nrm(ks[18], (L, D, D), D ** -0.5),
        "w_mlp1": nrm(ks[19], (L, D, D_FF), D ** -0.5),
        "w_mlp2": nrm(ks[20], (L, D_FF, D), D_FF ** -0.5),
        "final_norm_g": gain(ks[21], (D,)),
    }


def reference(x, c, ctx, c_ctx, w_ada, b_ada, norm1_g, norm2_g, w_in, b_gate, q_a_norm, w_uq,
              kv_a_norm, w_ukv, diff_lambda, diff_subln, w_o_diff, w_o_mla, w_out, w_mlp1,
              w_mlp2, final_norm_g):
    seq = x.shape[1]
    rope = axial_tables(seq)
    xc = ctx
    silu_c = jax.nn.silu(c)
    silu_cc = jax.nn.silu(c_ctx)
    for l in range(DEPTH):
        mod_x = (silu_c @ w_ada[l] + b_ada[l])[:, None, :]
        mod_c = silu_cc @ w_ada[l] + b_ada[l]
        sh1, sc1, g1, sh2, sc2, g2 = jnp.split(mod_x, N_MOD, axis=-1)
        csh1, csc1, cg1, csh2, csc2, cg2 = jnp.split(mod_c, N_MOD, axis=-1)
        lam_init = 0.8 - 0.6 * math.exp(-0.3 * l)
        dl = diff_lambda[l].astype(jnp.float32)
        lam = jnp.exp(jnp.sum(dl[0] * dl[1])) - jnp.exp(jnp.sum(dl[2] * dl[3])) + lam_init
        proj_w = (w_in[l], b_gate[l], q_a_norm[l], w_uq[l], kv_a_norm[l], w_ukv[l])
        mix_w = (lam, lam_init, diff_subln[l], w_o_diff[l], w_o_mla[l], w_out[l])

        hx = modulate(rmsnorm(x, norm1_g[l]), sh1, sc1)
        hc = modulate(rmsnorm(xc, norm1_g[l]), csh1, csc1)
        qx, kx, gx = mixer_projections(hx, *proj_w, rope)
        qc, kc, gc = mixer_projections(hc, *proj_w, None)
        keys_lat = tuple(jnp.concatenate([a, b], axis=1) for a, b in zip(kc, kx))
        x = x + g1 * mix(qx, keys_lat, gx, *mix_w)
        x = x + g2 * sq_relu_mlp(modulate(rmsnorm(x, norm2_g[l]), sh2, sc2), w_mlp1[l], w_mlp2[l])
        if l < DEPTH - 1:
            xc = xc + cg1 * mix(qc, kc, gc, *mix_w)
            xc = xc + cg2 * sq_relu_mlp(modulate(rmsnorm(xc, norm2_g[l]), csh2, csc2),
                                        w_mlp1[l], w_mlp2[l])
    return rmsnorm(x, final_norm_g)
```

```cpp
#include <hip/hip_runtime.h>
#include <cstdio>
#include <cstdint>

#ifndef MK_DEBUG
#define MK_DEBUG 0
#endif
#ifndef MK_MULTI
#define MK_MULTI 0
#endif

constexpr int DM = 2048, NBATCH = 16, SEQ = 2048, DEPTH = 4, CTXL = 256, DFF = 8192;
constexpr int MLAT = NBATCH * SEQ;
constexpr int MCTX = NBATCH * CTXL;
constexpr int MTOT = MLAT + MCTX;
constexpr int NIN = 8192;
constexpr int NMOD = 6 * DM;
constexpr float EPS = 1e-6f;
constexpr float MLA_SCALE = 0.07216878364870322f;
constexpr float LOG2E = 1.4426950408889634f;

constexpr size_t MiB = 1u << 20;
constexpr size_t WS_CTL = 0, CTL_ZERO_BYTES = 1 * MiB;
constexpr size_t WS_MOD = 1 * MiB;
constexpr size_t WS_ROPE = 5 * MiB;
constexpr size_t WS_SSQ = 6 * MiB;
constexpr size_t WS_W = 8 * MiB;
constexpr size_t W_IN = 0, W_UQ = W_IN + (size_t)NIN * DM, W_UKV = W_UQ + (size_t)1536 * 512, W_O = W_UKV + (size_t)2048 * 256,
                 W_OUT = W_O + (size_t)DM * DM, W_1 = W_OUT + (size_t)DM * DM, W_2 = W_1 + (size_t)DFF * DM, W_LAYER = W_2 + (size_t)DM * DFF;
constexpr size_t WS_XC = WS_W + ((DEPTH * W_LAYER * 2 + MiB - 1) / MiB) * MiB;
constexpr size_t WS_HB = WS_XC + (size_t)MCTX * DM * 4;
constexpr size_t WS_BIG = WS_HB + (size_t)MTOT * DM * 2;
constexpr size_t B_QD = 0, B_KD = B_QD + (size_t)MTOT * 1024 * 2, B_VD = B_KD + (size_t)MTOT * 1024 * 2, B_CQ = B_VD + (size_t)MTOT * 1024 * 2,
                 B_CKV = B_CQ + (size_t)MTOT * 512 * 2, B_KR = B_CKV + (size_t)MTOT * 256 * 2, B_G = B_KR + (size_t)MTOT * 64 * 2,
                 B_QM = B_G + (size_t)MTOT * 4096 * 2, B_KVM = B_QM + (size_t)MTOT * 1536 * 2, B_END = B_KVM + (size_t)MTOT * 2048 * 2;
constexpr size_t B_MG = 0;
constexpr size_t B_U = 0;
static_assert(B_KD + (size_t)MTOT * 1024 * 2 == (size_t)MTOT * 2048 * 2, "MG overlays exactly QD|KD");
static_assert((size_t)MTOT * DFF * 2 <= B_END, "U fits in BIG");
constexpr size_t WS_SNAP = WS_BIG + B_END;
constexpr size_t WS_END = WS_SNAP + 2 * MiB;
static_assert(WS_END < 1600000000ull, "workspace budget");

constexpr int CW_TMO = 0, CW_CODE = 1;
constexpr int CW_ERR = 64;
constexpr int CW_BAR = 4096;

constexpr int LDS_BYTES = 163840;
constexpr int RING_BYTES = 131072;
constexpr int MISC_OFF = LDS_BYTES - 256;

#define GAS __attribute__((address_space(1)))
#define LAS __attribute__((address_space(3)))
typedef unsigned short bf16;
typedef unsigned v4u __attribute__((ext_vector_type(4)));
typedef unsigned v2u __attribute__((ext_vector_type(2)));
typedef float f32x4 __attribute__((ext_vector_type(4)));
typedef float f32x2 __attribute__((ext_vector_type(2)));
typedef GAS unsigned gu32;
#define RLX_AGENT __ATOMIC_RELAXED, __HIP_MEMORY_SCOPE_AGENT
#define LDS_WAIT() asm volatile("s_waitcnt lgkmcnt(0)" ::: "memory")
#define VM_WAIT() asm volatile("s_waitcnt vmcnt(0)" ::: "memory")
__device__ __forceinline__ unsigned f2bf(float f) { unsigned u = __builtin_bit_cast(unsigned, f); return (u + 0x7fffu + ((u >> 16) & 1u)) >> 16; }
__device__ __forceinline__ unsigned pk2(float lo, float hi) { return f2bf(lo) | (f2bf(hi) << 16); }
__device__ __forceinline__ float bf2f(unsigned h) { return __builtin_bit_cast(float, h << 16); }
__device__ __forceinline__ float bflo(unsigned w) { return __builtin_bit_cast(float, w << 16); }
__device__ __forceinline__ float bfhi(unsigned w) { return __builtin_bit_cast(float, w & 0xffff0000u); }
__device__ __forceinline__ float wave_sum(float v) {
#pragma unroll
    for (int o = 1; o < 64; o <<= 1) v += __shfl_xor(v, o);
    return v;
}
namespace pg8 {
#define PG8_LAS __attribute__((address_space(3)))
typedef unsigned short bf16_t;
typedef short bf16x8 __attribute__((ext_vector_type(8)));
typedef float f32x4 __attribute__((ext_vector_type(4)));
typedef unsigned u32x4 __attribute__((ext_vector_type(4)));
constexpr int BM = 256, BK = 64, HALF = 128, HTB = HALF * BK * 2  , STAGE_BYTES = 8 * HTB, NXCD = 8, WGM = 8;

__host__ __device__ __forceinline__ int lds_byte(int r, int c) { const int st = (r >> 4) * 2 + (c >> 5), rr = r & 15, cc = c & 31, ob = rr * 64 + cc * 2; return st * 1024 + (ob ^ (((ob >> 9) & 1) << 5)); }
__host__ __device__ __forceinline__ void stage_rc(int b, int& R, int& C) { const int st = b / 1024, sb = b % 1024, swz = sb ^ (((sb >> 9) & 1) << 5); R = (st >> 1) * 16 + swz / 64; C = (st & 1) * 32 + (swz % 64) / 2; }
__host__ __device__ __forceinline__ int perm32(int rho) { const int n = rho >> 4, i = rho & 15; return 8 * (i >> 2) + 4 * n + (i & 3); }

struct Unit { int pm, pn; };
struct Gemm { const bf16_t* A; const bf16_t* Bt; int M, N, K; };

struct StaticOrder {
    int nM, nN, nwg, G, c;
    __host__ __device__ void init(int M, int N, int G_, int c_) { nM = M / BM; nN = N / BM; nwg = nM * nN; G = G_; c = c_; }
    __host__ __device__ bool next(int i, Unit& u) const {
        const long L = (long)i * G + c; if (L >= nwg) return false;
        int wgid = (int)L; { const int q = nwg / NXCD, r = nwg % NXCD, xcd = wgid % NXCD, off = wgid / NXCD; wgid = (xcd < r ? xcd * (q + 1) : r * (q + 1) + (xcd - r) * q) + off; }
        const int nig = WGM * nN, gid = wgid / nig, fm = gid * WGM, gsz = (nM - fm) < WGM ? (nM - fm) : WGM;
        u.pm = fm + ((wgid % nig) % gsz); u.pn = (wgid % nig) / gsz; return true;
    }
    __device__ __forceinline__ void a_ready(const Unit&) const {}
    __device__ __forceinline__ void done(const Unit&) const {}
};

typedef float cvt_f32x2_t __attribute__((ext_vector_type(2))); typedef __bf16 cvt_bf16x2_t __attribute__((ext_vector_type(2)));
__device__ __forceinline__ unsigned cvt_pk_bf16(float lo, float hi) { cvt_f32x2_t v = {lo, hi}; cvt_bf16x2_t b = __builtin_convertvector(v, cvt_bf16x2_t); return __builtin_bit_cast(unsigned, b); }
typedef float f32x2 __attribute__((ext_vector_type(2)));
__device__ __forceinline__ void st8(bf16_t* p, const f32x4 a, const f32x4 b) {
    u32x4 w; w.x = cvt_pk_bf16(a[0], a[1]); w.y = cvt_pk_bf16(a[2], a[3]); w.z = cvt_pk_bf16(b[0], b[1]); w.w = cvt_pk_bf16(b[2], b[3]); *(u32x4*)p = w;
}
__device__ __forceinline__ float blo(unsigned w) { return __builtin_bit_cast(float, w << 16); }
__device__ __forceinline__ float bhi(unsigned w) { return __builtin_bit_cast(float, w & 0xffff0000u); }
__device__ __forceinline__ void rope8(f32x4& a, f32x4& b, const float* rp, bool first_half) {
    const f32x4 t0 = *(const f32x4*)(rp), t1 = *(const f32x4*)(rp + 4), t2 = *(const f32x4*)(rp + 8), t3 = *(const f32x4*)(rp + 12);
    f32x4 pa, pb;
#pragma unroll
    for (int e = 0; e < 4; ++e) { pa[e] = __shfl_xor(a[e], 32); pb[e] = __shfl_xor(b[e], 32); }
    const float sg = first_half ? -1.f : 1.f;
    a[0] = a[0] * t0[0] + sg * pa[0] * t0[1]; a[1] = a[1] * t0[2] + sg * pa[1] * t0[3];
    a[2] = a[2] * t1[0] + sg * pa[2] * t1[1]; a[3] = a[3] * t1[2] + sg * pa[3] * t1[3];
    b[0] = b[0] * t2[0] + sg * pb[0] * t2[1]; b[1] = b[1] * t2[2] + sg * pb[1] * t2[3];
    b[2] = b[2] * t3[0] + sg * pb[2] * t3[1]; b[3] = b[3] * t3[2] + sg * pb[3] * t3[3];
}

struct EpiInProj {
    static constexpr bool PERM = true, AFTER_DRAIN = false, MIDHOOK = false;
    bf16_t *QD, *KD, *VD, *CQ, *CKV, *KR, *G; float* SSQ; const float* bgate; const float* rope;
    __device__ __forceinline__ void operator()(const f32x4 (&acc)[2][2][4][2], const Unit& u, int wr, int wc, int fr, int fq) const {
        const int pn = u.pn, cw = wc * 32 + 8 * fq; int rowb = u.pm * BM + wr * 64 + fr; asm volatile("" : "+v"(rowb)); const bool lat = u.pm < 128;
        const int ridx = (16 * (wc & 1) + 8 * (fq & 1)) * 2;
        if (pn < 8) {
            bf16_t* dst = (pn < 4) ? QD : KD; const int colt = (pn & 3) * 256; const float sc = (pn < 4) ? 0.125f : 1.0f;
#pragma unroll
            for (int ai = 0; ai < 2; ++ai)
#pragma unroll
                for (int m = 0; m < 4; ++m) { const int row = rowb + ai * HALF + m * 16; const float* rp = rope + (size_t)(row & 2047) * 64 + ridx;
#pragma unroll
                    for (int bj = 0; bj < 2; ++bj) { f32x4 a = acc[ai][bj][m][0], b = acc[ai][bj][m][1];
                        if (lat) rope8(a, b, rp, fq < 2);
                        st8(dst + (size_t)row * 1024 + colt + bj * HALF + cw, a * sc, b * sc); }
                    asm volatile("" ::: "memory"); }
        } else if (pn < 12) {
            const int colt = (pn - 8) * 256;
#pragma unroll
            for (int ai = 0; ai < 2; ++ai)
#pragma unroll
                for (int m = 0; m < 4; ++m) { const int row = rowb + ai * HALF + m * 16;
#pragma unroll
                    for (int bj = 0; bj < 2; ++bj) st8(VD + (size_t)row * 1024 + colt + bj * HALF + cw, acc[ai][bj][m][0], acc[ai][bj][m][1]); }
        } else if (pn < 15) {
            bf16_t* dst = (pn < 14) ? CQ : CKV; const int ld = (pn < 14) ? 512 : 256, colt = (pn == 13) ? 256 : 0, slot = (pn - 12) * 4 + wc;
#pragma unroll
            for (int ai = 0; ai < 2; ++ai)
#pragma unroll
                for (int m = 0; m < 4; ++m) { const int row = rowb + ai * HALF + m * 16; float s = 0.f;
#pragma unroll
                    for (int bj = 0; bj < 2; ++bj) { const f32x4 a = acc[ai][bj][m][0], b = acc[ai][bj][m][1];
                        s += (a[0] * a[0] + a[1] * a[1]) + (a[2] * a[2] + a[3] * a[3]) + (b[0] * b[0] + b[1] * b[1]) + (b[2] * b[2] + b[3] * b[3]);
                        st8(dst + (size_t)row * ld + colt + bj * HALF + cw, a, b); }
                    s += __shfl_xor(s, 16); s += __shfl_xor(s, 32);
                    if (fq == 0) SSQ[(size_t)row * 12 + slot] = s; }
        } else if (pn == 15) {
#pragma unroll
            for (int ai = 0; ai < 2; ++ai)
#pragma unroll
                for (int m = 0; m < 4; ++m) { const int row = rowb + ai * HALF + m * 16; const float* rp = rope + (size_t)(row & 2047) * 64 + ridx;
                    f32x4 a = acc[ai][0][m][0], b = acc[ai][0][m][1];
                    if (lat) rope8(a, b, rp, fq < 2);
                    if (wc < 2) st8(KR + (size_t)row * 64 + cw, a, b); }
        } else {
            const int colt = (pn - 16) * 256;
            f32x4 bv[2][2];
#pragma unroll
            for (int bj = 0; bj < 2; ++bj)
#pragma unroll
                for (int n = 0; n < 2; ++n) bv[bj][n] = *(const f32x4*)(bgate + colt + bj * HALF + cw + 4 * n);
#pragma unroll
            for (int ai = 0; ai < 2; ++ai)
#pragma unroll
                for (int m = 0; m < 4; ++m) { const int row = rowb + ai * HALF + m * 16;
#pragma unroll
                    for (int bj = 0; bj < 2; ++bj) { f32x4 v[2];
#pragma unroll
                        for (int n = 0; n < 2; ++n) { const f32x4 z = acc[ai][bj][m][n] + bv[bj][n];
#pragma unroll
                            for (int e = 0; e < 4; ++e) v[n][e] = __builtin_amdgcn_rcpf(1.0f + __expf(-z[e])); }
                        st8(G + (size_t)row * 4096 + colt + bj * HALF + cw, v[0], v[1]); } }
        }
    }
};

template <bool ISQ> struct EpiUp {
    static constexpr bool PERM = true, AFTER_DRAIN = false, MIDHOOK = false;
    bf16_t* O; const float* SSQ; const float* rope;
    __device__ __forceinline__ void operator()(const f32x4 (&acc)[2][2][4][2], const Unit& u, int wr, int wc, int fr, int fq) const {
        const int pn = u.pn, cw = wc * 32 + 8 * fq; int rowb = u.pm * BM + wr * 64 + fr; asm volatile("" : "+v"(rowb)); const bool lat = u.pm < 128;
        const int ridx = (16 * (wc & 1) + 8 * (fq & 1)) * 2; constexpr int ld = ISQ ? 1536 : 2048; const bool dorope = ISQ && pn >= 4 && lat;
#pragma unroll
        for (int ai = 0; ai < 2; ++ai)
#pragma unroll
            for (int m = 0; m < 4; ++m) { const int row = rowb + ai * HALF + m * 16; const float* sp = SSQ + (size_t)row * 12; float rs;
                if (ISQ) { const f32x4 s0 = *(const f32x4*)sp, s1 = *(const f32x4*)(sp + 4); rs = __builtin_amdgcn_rsqf(((s0[0] + s0[1]) + (s0[2] + s0[3]) + (s1[0] + s1[1]) + (s1[2] + s1[3])) * (1.0f / 512.0f) + EPS); }
                else { const f32x4 s0 = *(const f32x4*)(sp + 8); rs = __builtin_amdgcn_rsqf(((s0[0] + s0[1]) + (s0[2] + s0[3])) * (1.0f / 256.0f) + EPS); }
                const float* rp = rope + (size_t)(row & 2047) * 64 + ridx;
#pragma unroll
                for (int bj = 0; bj < 2; ++bj) { f32x4 a = acc[ai][bj][m][0] * rs, b = acc[ai][bj][m][1] * rs;
                    if (dorope) rope8(a, b, rp, fq < 2);
                    st8(O + (size_t)row * ld + pn * 256 + bj * HALF + cw, a, b); }
                asm volatile("" ::: "memory"); }
    }
};

struct EpiMerge {
    static constexpr bool PERM = true, AFTER_DRAIN = false, MIDHOOK = true;
    bf16_t* MG; const bf16_t* G;
    __device__ __forceinline__ void mid(f32x4 (&acc)[2][2][4][2], const Unit& u, int wr, int wc, int fr, int fq) const {
        const int col0 = u.pn * 256 + wc * 32 + 8 * fq; int rowb = u.pm * BM + wr * 64 + fr; asm volatile("" : "+v"(rowb));
#pragma unroll
        for (int ai = 0; ai < 2; ++ai)
#pragma unroll
            for (int m = 0; m < 4; ++m) { const bf16_t* gp = G + (size_t)(rowb + ai * HALF + m * 16) * 4096 + col0;
#pragma unroll
                for (int bj = 0; bj < 2; ++bj) { const u32x4 gd = *(const u32x4*)(gp + bj * HALF), gm = *(const u32x4*)(gp + 2048 + bj * HALF);
                    f32x4 r0, r1;
                    r0[0] = blo(gd.x) * __builtin_amdgcn_rcpf(blo(gm.x)); r0[1] = bhi(gd.x) * __builtin_amdgcn_rcpf(bhi(gm.x)); r0[2] = blo(gd.y) * __builtin_amdgcn_rcpf(blo(gm.y)); r0[3] = bhi(gd.y) * __builtin_amdgcn_rcpf(bhi(gm.y));
                    r1[0] = blo(gd.z) * __builtin_amdgcn_rcpf(blo(gm.z)); r1[1] = bhi(gd.z) * __builtin_amdgcn_rcpf(bhi(gm.z)); r1[2] = blo(gd.w) * __builtin_amdgcn_rcpf(blo(gm.w)); r1[3] = bhi(gd.w) * __builtin_amdgcn_rcpf(bhi(gm.w));
                    acc[ai][bj][m][0] *= r0; acc[ai][bj][m][1] *= r1; }
                asm volatile("" : "+v"(acc[ai][0][m][0]), "+v"(acc[ai][0][m][1]), "+v"(acc[ai][1][m][0]), "+v"(acc[ai][1][m][1]));
                asm volatile("" ::: "memory"); }
    }
    __device__ __forceinline__ void operator()(const f32x4 (&acc)[2][2][4][2], const Unit& u, int wr, int wc, int fr, int fq) const {
        const int col0 = u.pn * 256 + wc * 32 + 8 * fq; int rowb = u.pm * BM + wr * 64 + fr; asm volatile("" : "+v"(rowb));
#pragma unroll
        for (int ai = 0; ai < 2; ++ai)
#pragma unroll
            for (int m = 0; m < 4; ++m) { const int row = rowb + ai * HALF + m * 16; const bf16_t* gp = G + (size_t)row * 4096 + 2048 + col0;
#pragma unroll
                for (int bj = 0; bj < 2; ++bj) { const u32x4 gm = *(const u32x4*)(gp + bj * HALF);
                    const f32x4 g0 = (f32x4){blo(gm.x), bhi(gm.x), blo(gm.y), bhi(gm.y)}, g1 = (f32x4){blo(gm.z), bhi(gm.z), blo(gm.w), bhi(gm.w)};
                    st8(MG + (size_t)row * 2048 + col0 + bj * HALF, acc[ai][bj][m][0] * g0, acc[ai][bj][m][1] * g1); }
                asm volatile("" ::: "memory"); }
    }
};

struct EpiResid {
    static constexpr bool PERM = false, AFTER_DRAIN = false, MIDHOOK = false;
    float* xo; const float* xs; float* co; const float* cs; const float* gate;
    __device__ __forceinline__ void operator()(const f32x4 (&acc)[2][2][4][2], const Unit& u, int wr, int wc, int fr, int fq) const {
        const bool lat = u.pm < 128; const int col0 = u.pn * BM + wc * 32 + 4 * fq; int rowt = (lat ? u.pm : u.pm - 128) * BM + wr * 64 + fr; asm volatile("" : "+v"(rowt));
        float* ob = lat ? xo : co; const float* sb = lat ? xs : cs; const float* gp = gate + (size_t)(lat ? (u.pm >> 3) : 16) * 12288 + col0;
        f32x4 gv[2][2];
#pragma unroll
        for (int bj = 0; bj < 2; ++bj)
#pragma unroll
            for (int n = 0; n < 2; ++n) gv[bj][n] = *(const f32x4*)(gp + bj * HALF + n * 16);
#pragma unroll
        for (int ai = 0; ai < 2; ++ai)
#pragma unroll
            for (int m = 0; m < 4; ++m) { const size_t off = (size_t)(rowt + ai * HALF + m * 16) * 2048 + col0;
#pragma unroll
                for (int bj = 0; bj < 2; ++bj)
#pragma unroll
                    for (int n = 0; n < 2; ++n) { const f32x4 s = *(const f32x4*)(sb + off + bj * HALF + n * 16); *(f32x4*)(ob + off + bj * HALF + n * 16) = s + gv[bj][n] * acc[ai][bj][m][n]; }
                asm volatile("" ::: "memory"); }
    }
};

struct EpiRelu2 {
    static constexpr bool PERM = true, AFTER_DRAIN = false, MIDHOOK = false;
    bf16_t* U;
    __device__ __forceinline__ void operator()(const f32x4 (&acc)[2][2][4][2], const Unit& u, int wr, int wc, int fr, int fq) const {
        const int col0 = u.pn * 256 + wc * 32 + 8 * fq; int rowb = u.pm * BM + wr * 64 + fr; asm volatile("" : "+v"(rowb));
#pragma unroll
        for (int ai = 0; ai < 2; ++ai)
#pragma unroll
            for (int m = 0; m < 4; ++m) { bf16_t* rowp = U + (size_t)(rowb + ai * HALF + m * 16) * 8192 + col0;
#pragma unroll
                for (int bj = 0; bj < 2; ++bj) { f32x4 a = acc[ai][bj][m][0], b = acc[ai][bj][m][1];
#pragma unroll
                    for (int e = 0; e < 4; ++e) { const float x = fmaxf(a[e], 0.f), y = fmaxf(b[e], 0.f); a[e] = x * x; b[e] = y * y; }
                    st8(rowp + bj * HALF, a, b); } }
    }
};
template <class Epi, class Sched, bool ALIGN_EPI = false, bool SP2 = false>
__device__ __forceinline__ void gemm_phase(PG8_LAS unsigned char* lds, const Gemm g, const Sched& S, const Epi& E) {
    int tid_ = threadIdx.x; asm volatile("" : "+v"(tid_));
    const int tid = tid_, wid = __builtin_amdgcn_readfirstlane(tid >> 6), lane = tid & 63, wr = wid >> 2, wc = wid & 3, fr = lane & 15, fq = lane >> 4;
    int K_ = g.K; asm volatile("" : "+s"(K_));
    const int K = K_, nt = K / BK;
    unsigned voffA[2], voffB[2];
#pragma unroll
    for (int i = 0; i < 2; ++i) { int R, C; stage_rc(tid * 16 + i * 8192, R, C); const int Rb = Epi::PERM ? ((R & ~31) + perm32(R & 31)) : R;
        voffA[i] = (unsigned)(R * K + C) * 2u; voffB[i] = (unsigned)(Rb * K + C) * 2u; }
    const size_t kstep = (size_t)(BK * 2);
    const size_t hstep = (size_t)HALF * K * 2;
    const size_t tstep = 2 * hstep;
    const unsigned ldsw = (unsigned)wid * 1024u;
    const int aoff = lds_byte(wr * 64 + fr, fq * 8), boff = lds_byte(wc * 32 + fr, fq * 8);
#define PG8_SA(b, h) (((b) * 2 + (h)) * HTB)
#define PG8_SB(b, h) ((4 + (b) * 2 + (h)) * HTB)
#define PG8_STAGE(bufoff, gbase, voff) do { _Pragma("unroll") for (int _i = 0; _i < 2; ++_i) \
        __builtin_amdgcn_global_load_lds((const unsigned*)((const char*)(gbase) + (voff)[_i]), (PG8_LAS unsigned*)(lds + (bufoff) + ldsw + _i * 8192), 16, 0, 0); } while (0)
#define PG8_LDA(dst, b, h) do { _Pragma("unroll") for (int m = 0; m < 4; ++m) _Pragma("unroll") for (int k = 0; k < 2; ++k) dst[m][k] = *(const PG8_LAS bf16x8*)(lds + PG8_SA(b, h) + aoff + m * 2048 + k * 1024); } while (0)
#define PG8_LDB(dst, b, h) do { _Pragma("unroll") for (int n = 0; n < 2; ++n) _Pragma("unroll") for (int k = 0; k < 2; ++k) dst[n][k] = *(const PG8_LAS bf16x8*)(lds + PG8_SB(b, h) + boff + n * 2048 + k * 1024); } while (0)
#define PG8_MMA(ai, bj, At, Bt) do { __builtin_amdgcn_s_setprio(1); _Pragma("unroll") for (int m = 0; m < 4; ++m) _Pragma("unroll") for (int n = 0; n < 2; ++n) _Pragma("unroll") for (int k = 0; k < 2; ++k) \
        acc[ai][bj][m][n] = __builtin_amdgcn_mfma_f32_16x16x32_bf16(Bt[n][k], At[m][k], acc[ai][bj][m][n], 0, 0, 0); __builtin_amdgcn_s_setprio(0); } while (0)
#define PG8_WAIT_V(n) asm volatile("s_waitcnt vmcnt(" #n ")" ::: "memory")
#define PG8_WAIT_L(n) asm volatile("s_waitcnt lgkmcnt(" #n ")" ::: "memory")
#define PG8_BAR __builtin_amdgcn_s_barrier()
#define PG8_SCHED __builtin_amdgcn_sched_barrier(0)
    Unit cur, nxt; int ui = 0;
    if (!S.next(0, cur)) return;
    f32x4 acc[2][2][4][2];
#pragma unroll
    for (int a = 0; a < 2; ++a)
#pragma unroll
        for (int b = 0; b < 2; ++b)
#pragma unroll
            for (int m = 0; m < 4; ++m)
#pragma unroll
                for (int n = 0; n < 2; ++n) acc[a][b][m][n] = (f32x4){0.f, 0.f, 0.f, 0.f};
    bf16x8 At[4][2], B0[2][2], B1[2][2];
    const char* cA = (const char*)g.A + (size_t)cur.pm * tstep; const char* cB = (const char*)g.Bt + (size_t)cur.pn * tstep;
    S.a_ready(cur);
    if constexpr (SP2) {
        PG8_STAGE(PG8_SB(0, 0), cB, voffB); PG8_STAGE(PG8_SB(0, 1), cB + hstep, voffB); PG8_STAGE(PG8_SA(0, 0), cA, voffA); PG8_STAGE(PG8_SA(0, 1), cA + hstep, voffA);
        if (wr == 1) PG8_BAR;
        PG8_WAIT_V(2); PG8_BAR;
        PG8_STAGE(PG8_SB(1, 0), cB + kstep, voffB); PG8_STAGE(PG8_SA(1, 0), cA + kstep, voffA); PG8_STAGE(PG8_SB(1, 1), cB + hstep + kstep, voffB);
        PG8_WAIT_V(6); PG8_BAR;
    } else {
        PG8_STAGE(PG8_SB(0, 0), cB, voffB); PG8_STAGE(PG8_SA(0, 0), cA, voffA); PG8_STAGE(PG8_SB(0, 1), cB + hstep, voffB); PG8_STAGE(PG8_SA(0, 1), cA + hstep, voffA);
        if (wr == 1) PG8_BAR;
        PG8_WAIT_V(4); PG8_BAR;
        PG8_STAGE(PG8_SB(1, 0), cB + kstep, voffB); PG8_STAGE(PG8_SA(1, 0), cA + kstep, voffA); PG8_STAGE(PG8_SB(1, 1), cB + hstep + kstep, voffB);
        PG8_WAIT_V(6); PG8_BAR;
    }
    for (;;) {
        const bool has_next = S.next(ui + 1, nxt);
        const char* nA = has_next ? (const char*)g.A + (size_t)nxt.pm * tstep : cA; const char* nB = has_next ? (const char*)g.Bt + (size_t)nxt.pn * tstep : cB;
        for (int t = 0; t < nt; t += 2) {
            const bool last = (t == nt - 2);
            if constexpr (Epi::MIDHOOK) { if (t == (nt >> 1)) E.mid(acc, cur, wr, wc, fr, fq); }
            const char* a1 = cA + (size_t)(t + 1) * kstep;
            const char* a2 = last ? nA : cA + (size_t)(t + 2) * kstep; const char* b2 = last ? nB : cB + (size_t)(t + 2) * kstep;
            const char* a3 = a2 + kstep; const char* b3 = b2 + kstep;
            if (last && has_next) S.a_ready(nxt);
            if constexpr (SP2) {
            PG8_LDB(B0, 0, 0); PG8_LDB(B1, 0, 1); PG8_SCHED; PG8_LDA(At, 0, 0); PG8_STAGE(PG8_SA(1, 1), a1 + hstep, voffA);
            PG8_WAIT_V(8); PG8_WAIT_L(0); PG8_BAR; PG8_MMA(0, 0, At, B0); PG8_MMA(0, 1, At, B1); PG8_BAR; PG8_SCHED;
            PG8_LDA(At, 0, 1); PG8_STAGE(PG8_SB(0, 0), b2, voffB); PG8_STAGE(PG8_SB(0, 1), b2 + hstep, voffB); PG8_STAGE(PG8_SA(0, 0), a2, voffA);
            PG8_WAIT_V(8); PG8_WAIT_L(0); PG8_BAR; PG8_MMA(1, 0, At, B0); PG8_MMA(1, 1, At, B1); PG8_BAR; PG8_SCHED;
            PG8_LDB(B0, 1, 0); PG8_LDB(B1, 1, 1); PG8_SCHED; PG8_LDA(At, 1, 0); PG8_STAGE(PG8_SA(0, 1), a2 + hstep, voffA);
            PG8_WAIT_V(8); PG8_WAIT_L(0); PG8_BAR; PG8_MMA(0, 0, At, B0); PG8_MMA(0, 1, At, B1); PG8_BAR; PG8_SCHED;
            PG8_LDA(At, 1, 1); PG8_STAGE(PG8_SB(1, 0), b3, voffB); PG8_STAGE(PG8_SB(1, 1), b3 + hstep, voffB); PG8_STAGE(PG8_SA(1, 0), a3, voffA);
            PG8_WAIT_V(8); PG8_WAIT_L(0); PG8_BAR; PG8_MMA(1, 0, At, B0); PG8_MMA(1, 1, At, B1); PG8_BAR; PG8_SCHED;
            } else {
            PG8_LDB(B0, 0, 0); PG8_SCHED; PG8_LDA(At, 0, 0); PG8_STAGE(PG8_SA(1, 1), a1 + hstep, voffA);
            PG8_WAIT_L(8); PG8_BAR; PG8_WAIT_L(0); PG8_MMA(0, 0, At, B0); PG8_BAR; PG8_SCHED;
            PG8_LDB(B1, 0, 1); PG8_STAGE(PG8_SB(0, 0), b2, voffB);
            PG8_BAR; PG8_WAIT_L(0); PG8_MMA(0, 1, At, B1); PG8_BAR;
            PG8_LDA(At, 0, 1); PG8_STAGE(PG8_SA(0, 0), a2, voffA);
            PG8_BAR; PG8_WAIT_L(0); PG8_MMA(1, 0, At, B0); PG8_BAR; PG8_SCHED;
            PG8_STAGE(PG8_SB(0, 1), b2 + hstep, voffB);
            PG8_WAIT_V(6); PG8_BAR; PG8_MMA(1, 1, At, B1); PG8_BAR;
            PG8_LDB(B0, 1, 0); PG8_SCHED; PG8_LDA(At, 1, 0); PG8_STAGE(PG8_SA(0, 1), a2 + hstep, voffA);
            PG8_WAIT_L(8); PG8_BAR; PG8_WAIT_L(0); PG8_MMA(0, 0, At, B0); PG8_BAR; PG8_SCHED;
            PG8_LDB(B1, 1, 1); PG8_STAGE(PG8_SB(1, 0), b3, voffB);
            PG8_BAR; PG8_WAIT_L(0); PG8_MMA(0, 1, At, B1); PG8_BAR;
            PG8_LDA(At, 1, 1); PG8_STAGE(PG8_SA(1, 0), a3, voffA);
            PG8_BAR; PG8_WAIT_L(0); PG8_MMA(1, 0, At, B0); PG8_BAR; PG8_SCHED;
            PG8_STAGE(PG8_SB(1, 1), b3 + hstep, voffB);
            PG8_WAIT_V(6); PG8_BAR; PG8_MMA(1, 1, At, B1); PG8_BAR;
            }
        }
        if constexpr (ALIGN_EPI) { if (wr == 0) PG8_BAR; }
        if constexpr (!Epi::AFTER_DRAIN) { E(acc, cur, wr, wc, fr, fq); S.done(cur); }
        if (!has_next) break;
#pragma unroll
        for (int a = 0; a < 2; ++a)
#pragma unroll
            for (int b = 0; b < 2; ++b)
#pragma unroll
                for (int m = 0; m < 4; ++m)
#pragma unroll
                    for (int n = 0; n < 2; ++n) acc[a][b][m][n] = (f32x4){0.f, 0.f, 0.f, 0.f};
        cur = nxt; cA = nA; cB = nB; ++ui;
        if constexpr (ALIGN_EPI) { if (wr == 1) PG8_BAR; }
    }
    PG8_WAIT_V(0);
    if constexpr (!ALIGN_EPI) { if (wr == 0) PG8_BAR; }
    PG8_BAR;
    if constexpr (Epi::AFTER_DRAIN) { E.fused(acc, cur, wr, wc, fr, fq, lds, wid, lane); S.done(cur); }
#undef PG8_SA
#undef PG8_SB
#undef PG8_STAGE
#undef PG8_LDA
#undef PG8_LDB
#undef PG8_MMA
#undef PG8_WAIT_V
#undef PG8_WAIT_L
#undef PG8_BAR
#undef PG8_SCHED
}
}
#define XB_TMO      128
#define XB_XCNT(j)  (256  + 64 * (j))
#define XB_XSUB(j)  (1280 + 64 * (j))
#define XB_XGEN(j)  (2304 + 64 * (j))
#define XB_TOP      3328
#define XB_TOPGEN   3392
#define XCD_BAR_WORDS 3456
#define XB_SPIN_CAP (1u << 18)

__device__ __forceinline__ unsigned xb_ld(unsigned* p)              { return __hip_atomic_load(p, __ATOMIC_RELAXED, __HIP_MEMORY_SCOPE_AGENT); }
__device__ __forceinline__ unsigned xb_add(unsigned* p, unsigned v) { return __hip_atomic_fetch_add(p, v, __ATOMIC_RELAXED, __HIP_MEMORY_SCOPE_AGENT); }
__device__ __forceinline__ unsigned xb_xcc_id() { return (unsigned)__builtin_amdgcn_s_getreg((3 << 11) | 20) & 0xFu; }
#define XB_SPIN(cond, bar) do { unsigned _sp = 0; while (cond) { __builtin_amdgcn_s_sleep(1); \
    if ((++_sp & 255u) == 0u) { if (xb_ld(&(bar)[XB_TMO])) break; if (_sp > XB_SPIN_CAP) { atomicAdd(&(bar)[XB_TMO], 1u); break; } } } } while (0)

struct XcdBarrier {
    unsigned* bar; unsigned x;
    volatile LAS unsigned* st;
};

__device__ __forceinline__ XcdBarrier xcd_barrier_post(unsigned* bar, volatile LAS unsigned* st) {
    XcdBarrier b; b.bar = bar; b.x = xb_xcc_id(); b.st = st;
    if (threadIdx.x == 0) (void)xb_add(&bar[XB_XCNT(b.x)], 1u);
    return b;
}
__device__ __forceinline__ void xcd_barrier_complete(unsigned* bar, unsigned x, unsigned& nloc, unsigned& nx) {
    const unsigned G = gridDim.x * gridDim.y * gridDim.z;
    unsigned sum, cnt, mine, sp = 0u;
    for (;;) {
        sum = 0u; cnt = 0u; mine = 0u;
#pragma unroll
        for (unsigned j = 0; j < 16; ++j) { const unsigned c = xb_ld(&bar[XB_XCNT(j)]); sum += c; cnt += (c > 0u) ? 1u : 0u; mine = (j == x) ? c : mine; }
        if (sum == G) break;
        __builtin_amdgcn_s_sleep(1);
        if ((++sp & 255u) == 0u) { if (xb_ld(&bar[XB_TMO])) break; if (sp > XB_SPIN_CAP) { atomicAdd(&bar[XB_TMO], 1u); break; } }
    }
    nloc = mine > 0u ? mine : 1u; nx = cnt > 0u ? cnt : 1u;
}

__device__ __forceinline__ void xcd_barrier(const XcdBarrier& b) {
    asm volatile("s_waitcnt vmcnt(0)" ::: "memory");
    __syncthreads();
    if (threadIdx.x == 0) {
        unsigned* bar = b.bar;
        __builtin_amdgcn_s_waitcnt(0);
        unsigned nloc = b.st[0], nx = b.st[1];
        if (nloc == 0u) { xcd_barrier_complete(bar, b.x, nloc, nx); b.st[0] = nloc; b.st[1] = nx; }
        const unsigned old = xb_add(&bar[XB_XSUB(b.x)], 1u);
        const unsigned gen = old / nloc;
        if (old + 1u == (gen + 1u) * nloc) {
            __builtin_amdgcn_fence(__ATOMIC_RELEASE, "agent");
            asm volatile("s_waitcnt vmcnt(0)" ::: "memory");
            const unsigned og = xb_add(&bar[XB_TOP], 1u);
            const unsigned tg = og / nx;
            if (og + 1u == (tg + 1u) * nx) xb_add(&bar[XB_TOPGEN], 1u);
            else XB_SPIN(xb_ld(&bar[XB_TOPGEN]) == tg, bar);
            __builtin_amdgcn_fence(__ATOMIC_ACQUIRE, "agent");
            xb_add(&bar[XB_XGEN(b.x)], 1u);
            asm volatile("s_waitcnt vmcnt(0)" ::: "memory");
        } else {
            XB_SPIN(xb_ld(&bar[XB_XGEN(b.x)]) == gen, bar);
            __builtin_amdgcn_fence(__ATOMIC_ACQUIRE, "agent");
            asm volatile("s_waitcnt vmcnt(0)" ::: "memory");
        }
    }
    __syncthreads();
}
namespace att {
using bf16x8 = __attribute__((ext_vector_type(8))) short;
using s16x4  = __attribute__((ext_vector_type(4))) short;
using f32x16 = __attribute__((ext_vector_type(16))) float;
using u32x4  = __attribute__((ext_vector_type(4))) unsigned;
typedef LAS char* lptr;
#define ATT_SBAR() __builtin_amdgcn_sched_barrier(0)
constexpr int NW = 8, KVBLK = 64;
constexpr int SHM_V = 16384, SHM_K = 16384, SHM_KP = 8192;
constexpr int L_V = 0, L_K = 2 * SHM_V, L_KP = L_K + 2 * SHM_K, L_WS = L_KP + 2 * SHM_KP, L_END = L_WS + NW * 64 * 4;
__device__ __forceinline__ int kswz(int row, int colB) { return row * 256 + (colB ^ ((row & 7) << 4)); }
__device__ __forceinline__ int kswz64(int row, int colB) { return row * 128 + (colB ^ ((row & 7) << 4)); }
__device__ __forceinline__ int crow(int r, int hi) { return (r & 3) + 8 * (r >> 2) + 4 * hi; }
typedef float cvt_f32x2_t __attribute__((ext_vector_type(2))); typedef __bf16 cvt_bf16x2_t __attribute__((ext_vector_type(2)));
__device__ __forceinline__ unsigned cvtpk(float lo, float hi) { cvt_f32x2_t v = {lo, hi}; cvt_bf16x2_t b = __builtin_convertvector(v, cvt_bf16x2_t); return __builtin_bit_cast(unsigned, b); }
__device__ __forceinline__ int v_st(int k, int c) { const int kk = (k & ~0xC) | ((k & 4) << 1) | ((k & 8) >> 1); return ((kk >> 3) * 4 + (c >> 5)) * 512 + ((kk & 7) * 32 + (c & 31)) * 2; }
__device__ __forceinline__ int v_rd_base(int lane) { return ((lane & 3) << 3) | (((lane >> 2) & 3) << 6) | (((lane >> 4) & 1) << 5) | (((lane >> 5) & 1) << 8); }
constexpr int v_rd_off(int d0, int ks, int half) { return d0 * 512 + ks * 4096 + half * 2048; }
template <int OFF> __device__ __forceinline__ s16x4 tr_read(int vb) { s16x4 r; asm volatile("ds_read_b64_tr_b16 %0, %1 offset:%2" : "=&v"(r) : "v"(vb), "i"(OFF) : "memory"); return r; }
template <int D0> __device__ __forceinline__ void pv_one(f32x16& od, int vb, bf16x8 pa0, bf16x8 pa1, bf16x8 pa2, bf16x8 pa3) {
    const s16x4 l0 = tr_read<v_rd_off(D0, 0, 0)>(vb), h0 = tr_read<v_rd_off(D0, 0, 1)>(vb), l1 = tr_read<v_rd_off(D0, 1, 0)>(vb), h1 = tr_read<v_rd_off(D0, 1, 1)>(vb);
    const s16x4 l2 = tr_read<v_rd_off(D0, 2, 0)>(vb), h2 = tr_read<v_rd_off(D0, 2, 1)>(vb), l3 = tr_read<v_rd_off(D0, 3, 0)>(vb), h3 = tr_read<v_rd_off(D0, 3, 1)>(vb);
    asm volatile("s_waitcnt lgkmcnt(0)" ::: "memory"); ATT_SBAR();
#define ATT_PK(L, H) (bf16x8){L[0], L[1], L[2], L[3], H[0], H[1], H[2], H[3]}
    od = __builtin_amdgcn_mfma_f32_32x32x16_bf16(pa0, ATT_PK(l0, h0), od, 0, 0, 0);
    od = __builtin_amdgcn_mfma_f32_32x32x16_bf16(pa1, ATT_PK(l1, h1), od, 0, 0, 0);
    od = __builtin_amdgcn_mfma_f32_32x32x16_bf16(pa2, ATT_PK(l2, h2), od, 0, 0, 0);
    od = __builtin_amdgcn_mfma_f32_32x32x16_bf16(pa3, ATT_PK(l3, h3), od, 0, 0, 0);
#undef ATT_PK
}
__device__ __forceinline__ void pv_d0(f32x16* o, int vb, bf16x8 pa0, bf16x8 pa1, bf16x8 pa2, bf16x8 pa3) {
    pv_one<0>(o[0], vb, pa0, pa1, pa2, pa3); pv_one<1>(o[1], vb, pa0, pa1, pa2, pa3); pv_one<2>(o[2], vb, pa0, pa1, pa2, pa3); pv_one<3>(o[3], vb, pa0, pa1, pa2, pa3);
}
__device__ __forceinline__ bf16x8 ldg8(const bf16* p) { return *reinterpret_cast<const bf16x8*>(p); }

struct Args {
    const bf16 *QD, *KD, *VD, *QM, *KVM, *KR; bf16* Y; const float* subln; float lam, omli;
};

template <int MODE>
__device__ __forceinline__ void attn_unit(const Args& A, int b, int h, int qb, bool isctx, lptr lds) {
    int tid_ = threadIdx.x; asm volatile("" : "+v"(tid_));
    const int tid = tid_, lane = tid & 63, r32 = lane & 31, hi = lane >> 5; const int wid = __builtin_amdgcn_readfirstlane(tid >> 6);
    const int comp = (MODE == 0) ? (wid >> 2) : 0, wq = (MODE == 0) ? (wid & 3) : wid;
    constexpr int QROWS = (MODE == 0) ? 128 : 256;
    const int ctx0 = MLAT + b * CTXL, lat0 = b * SEQ;
    const int qrow0 = (isctx ? ctx0 : lat0) + qb * QROWS + wq * 32;
    const int NT = isctx ? 4 : 36;
    constexpr float C = (MODE == 0) ? LOG2E : MLA_SCALE * LOG2E;
    constexpr int NQ = (MODE == 0) ? 4 : 12;
    bf16x8 qr[NQ];
    if constexpr (MODE == 0) { const bf16* qp = A.QD + (size_t)(qrow0 + r32) * 1024 + h * 128 + comp * 64 + hi * 8;
#pragma unroll
        for (int d0 = 0; d0 < 4; ++d0) qr[d0] = ldg8(qp + d0 * 16);
    } else { const bf16* qp = A.QM + (size_t)(qrow0 + r32) * 1536 + h * 128 + hi * 8; const bf16* qe = A.QM + (size_t)(qrow0 + r32) * 1536 + 1024 + h * 64 + hi * 8;
#pragma unroll
        for (int d0 = 0; d0 < 8; ++d0) qr[d0] = ldg8(qp + d0 * 16);
#pragma unroll
        for (int d0 = 0; d0 < 4; ++d0) qr[8 + d0] = ldg8(qe + d0 * 16);
    }
    const int sr = tid >> 4, sc = (tid & 15) * 8, vst0 = v_st(sr, sc), vst1 = v_st(32 + sr, sc), kst0 = kswz(sr, sc * 2), kst1 = kswz(32 + sr, sc * 2);
    const int pr = tid >> 3, pc = (tid & 7) * 8, pst = kswz64(pr, pc * 2);
    const bf16* Kg = (MODE == 0) ? A.KD + h * 128 : A.KVM + h * 128; const bf16* Vg = (MODE == 0) ? A.VD + h * 128 : A.KVM + 1024 + h * 128;
    constexpr int LDK = (MODE == 0) ? 1024 : 2048;
    bf16x8 vs0, vs1, ks0, ks1, kp0;
#define ATT_KROW(j) ((j) < 4 ? ctx0 + 64 * (j) : lat0 + 64 * ((j) - 4))
#define ATT_SLOAD(j) do { const int k0_ = ATT_KROW(j); \
        vs0 = ldg8(Vg + (size_t)(k0_ + sr) * LDK + sc); vs1 = ldg8(Vg + (size_t)(k0_ + 32 + sr) * LDK + sc); \
        ks0 = ldg8(Kg + (size_t)(k0_ + sr) * LDK + sc); ks1 = ldg8(Kg + (size_t)(k0_ + 32 + sr) * LDK + sc); \
        if constexpr (MODE == 1) kp0 = ldg8(A.KR + (size_t)(k0_ + pr) * 64 + pc); } while (0)
#define ATT_SWRITE(bb) do { *(LAS bf16x8*)(lds + L_V + (bb) * SHM_V + vst0) = vs0; *(LAS bf16x8*)(lds + L_V + (bb) * SHM_V + vst1) = vs1; \
        *(LAS bf16x8*)(lds + L_K + (bb) * SHM_K + kst0) = ks0; *(LAS bf16x8*)(lds + L_K + (bb) * SHM_K + kst1) = ks1; \
        if constexpr (MODE == 1) *(LAS bf16x8*)(lds + L_KP + (bb) * SHM_KP + pst) = kp0; } while (0)
    LAS float* wsf = (LAS float*)(lds + L_WS) + wid * 64;
    const int vb0 = (int)(uintptr_t)(lds + L_V) + v_rd_base(lane);
    float m_reg = -1e30f, l_reg = 0.f; f32x16 o[4];
#pragma unroll
    for (int d = 0; d < 4; ++d) o[d] = f32x16{};
    ATT_SLOAD(0); ATT_SWRITE(0); __syncthreads();
    for (int j = 0; j < NT; ++j) {
        const int cur = j & 1;
        if (j + 1 < NT) ATT_SLOAD(j + 1);
        f32x16 p0 = f32x16{}, p1 = f32x16{};
        { const lptr Kb = lds + L_K + cur * SHM_K;
          if constexpr (MODE == 0) {
#pragma unroll
            for (int d0 = 0; d0 < 4; ++d0) { const int cb = (comp * 64 + d0 * 16 + hi * 8) * 2;
                const bf16x8 b0 = *(const LAS bf16x8*)(Kb + kswz(r32, cb)), b1 = *(const LAS bf16x8*)(Kb + kswz(32 + r32, cb));
                p0 = __builtin_amdgcn_mfma_f32_32x32x16_bf16(b0, qr[d0], p0, 0, 0, 0); p1 = __builtin_amdgcn_mfma_f32_32x32x16_bf16(b1, qr[d0], p1, 0, 0, 0); }
          } else {
#pragma unroll
            for (int d0 = 0; d0 < 8; ++d0) { const int cb = (d0 * 16 + hi * 8) * 2;
                const bf16x8 b0 = *(const LAS bf16x8*)(Kb + kswz(r32, cb)), b1 = *(const LAS bf16x8*)(Kb + kswz(32 + r32, cb));
                p0 = __builtin_amdgcn_mfma_f32_32x32x16_bf16(b0, qr[d0], p0, 0, 0, 0); p1 = __builtin_amdgcn_mfma_f32_32x32x16_bf16(b1, qr[d0], p1, 0, 0, 0); }
            const lptr Pb = lds + L_KP + cur * SHM_KP;
#pragma unroll
            for (int d0 = 0; d0 < 4; ++d0) { const int cb = (d0 * 16 + hi * 8) * 2;
                const bf16x8 b0 = *(const LAS bf16x8*)(Pb + kswz64(r32, cb)), b1 = *(const LAS bf16x8*)(Pb + kswz64(32 + r32, cb));
                p0 = __builtin_amdgcn_mfma_f32_32x32x16_bf16(b0, qr[8 + d0], p0, 0, 0, 0); p1 = __builtin_amdgcn_mfma_f32_32x32x16_bf16(b1, qr[8 + d0], p1, 0, 0, 0); }
          } }
        float pmax = p0[0];
#pragma unroll
        for (int r = 1; r < 16; ++r) pmax = fmaxf(pmax, p0[r]);
#pragma unroll
        for (int r = 0; r < 16; ++r) pmax = fmaxf(pmax, p1[r]);
        { auto rr = __builtin_amdgcn_permlane32_swap(__float_as_uint(pmax), __float_as_uint(pmax), false, false); pmax = fmaxf(__uint_as_float(rr[0]), __uint_as_float(rr[1])); }
        const float mn = fmaxf(m_reg, pmax), alpha = __builtin_amdgcn_exp2f((m_reg - mn) * C); m_reg = mn;
        const float mnC = -mn * C;
#pragma unroll
        for (int r = 0; r < 16; ++r) { p0[r] = __builtin_amdgcn_exp2f(fmaf(p0[r], C, mnC)); p1[r] = __builtin_amdgcn_exp2f(fmaf(p1[r], C, mnC)); }
        float ps = 0.f;
#pragma unroll
        for (int r = 0; r < 16; ++r) ps += p0[r] + p1[r];
        { auto rr = __builtin_amdgcn_permlane32_swap(__float_as_uint(ps), __float_as_uint(ps), false, false); ps = __uint_as_float(rr[0]) + __uint_as_float(rr[1]); }
        l_reg = l_reg * alpha + ps;
        bf16x8 pa0, pa1, pa2, pa3;
#define ATT_PK4(P, BASE, OUT) do { unsigned a0 = cvtpk(P[BASE + 0], P[BASE + 1]), a1 = cvtpk(P[BASE + 2], P[BASE + 3]); \
        unsigned b0 = cvtpk(P[BASE + 4], P[BASE + 5]), b1 = cvtpk(P[BASE + 6], P[BASE + 7]); \
        auto r0 = __builtin_amdgcn_permlane32_swap(a0, b0, false, false); auto r1 = __builtin_amdgcn_permlane32_swap(a1, b1, false, false); \
        u32x4 w = {r0[0], r1[0], r0[1], r1[1]}; OUT = __builtin_bit_cast(bf16x8, w); } while (0)
        ATT_PK4(p0, 0, pa0); ATT_PK4(p0, 8, pa1); ATT_PK4(p1, 0, pa2); ATT_PK4(p1, 8, pa3);
#undef ATT_PK4
        if (__any(alpha < 1.f)) { if (hi == 0) wsf[r32] = alpha; asm volatile("s_waitcnt lgkmcnt(0)" ::: "memory");
#pragma unroll
            for (int r = 0; r < 16; ++r) { const float al = wsf[crow(r, hi)];
#pragma unroll
                for (int d = 0; d < 4; ++d) o[d][r] *= al; }
            asm volatile("s_waitcnt lgkmcnt(0)" ::: "memory"); }
        ATT_SBAR();
        pv_d0(o, vb0 + cur * SHM_V, pa0, pa1, pa2, pa3);
        if (j + 1 < NT) ATT_SWRITE(cur ^ 1);
        __syncthreads();
    }
    if (hi == 0) wsf[32 + r32] = l_reg; asm volatile("s_waitcnt lgkmcnt(0)" ::: "memory");
    float rli[16];
#pragma unroll
    for (int r = 0; r < 16; ++r) rli[r] = 1.0f / wsf[32 + crow(r, hi)];
    asm volatile("s_waitcnt lgkmcnt(0)" ::: "memory");
    if constexpr (MODE == 1) {
        bf16* Yp = A.Y + (size_t)qrow0 * 2048 + 1024 + h * 128 + r32;
#pragma unroll
        for (int r = 0; r < 16; ++r) { const int orow = crow(r, hi);
#pragma unroll
            for (int d = 0; d < 4; ++d) Yp[(size_t)orow * 2048 + d * 32] = (bf16)f2bf(o[d][r] * rli[r]); }
        __syncthreads();
    } else {
        LAS float* xch = (LAS float*)lds;
        if (comp == 1) {
#pragma unroll
            for (int d = 0; d < 4; ++d)
#pragma unroll
                for (int r = 0; r < 16; ++r) xch[(wq * 64 + d * 16 + r) * 64 + lane] = A.lam * (o[d][r] * rli[r]);
        }
        __syncthreads();
        if (comp == 0) {
            bf16* Yp = A.Y + (size_t)qrow0 * 2048 + h * 128 + r32;
            float g[4];
#pragma unroll
            for (int d = 0; d < 4; ++d) g[d] = A.subln[d * 32 + r32] * A.omli;
#pragma unroll
            for (int r = 0; r < 16; ++r) { float v[4]; float ss = 0.f;
#pragma unroll
                for (int d = 0; d < 4; ++d) { v[d] = o[d][r] * rli[r] - xch[(wq * 64 + d * 16 + r) * 64 + lane]; ss += v[d] * v[d]; }
                ss += __shfl_xor(ss, 1); ss += __shfl_xor(ss, 2); ss += __shfl_xor(ss, 4); ss += __shfl_xor(ss, 8); ss += __shfl_xor(ss, 16);
                const float rs = 1.0f / sqrtf(ss * (1.0f / 128.0f) + EPS); const int orow = crow(r, hi);
#pragma unroll
                for (int d = 0; d < 4; ++d) Yp[(size_t)orow * 2048 + d * 32] = (bf16)f2bf(v[d] * rs * g[d]); }
        }
        __syncthreads();
    }
#undef ATT_KROW
#undef ATT_SLOAD
#undef ATT_SWRITE
}
#undef ATT_SBAR
}
struct Args {
    const float *x, *c, *ctx, *c_ctx, *w_ada, *b_ada, *norm1_g, *norm2_g, *w_in, *b_gate, *q_a_norm, *w_uq, *kv_a_norm, *w_ukv, *diff_lambda, *diff_subln,
                *w_o_diff, *w_o_mla, *w_out, *w_mlp1, *w_mlp2, *final_norm_g;
    float* out; unsigned char* ws; int ph_lo, ph_hi;
};
constexpr int NPHASE = 2 + 9 * DEPTH;
constexpr int NWAVES = 8;

__device__ __forceinline__ void p0_item(const float* W, int ldw, int k0, int srccol, bf16* WT, int ldt, int dstrow, int dstk, const float* gain, LAS float* scr, int lane) {
    if (srccol < 0) {
        const int c = lane & 7;
#pragma unroll
        for (int j = 0; j < 4; ++j) { const int n = (lane >> 3) + 8 * j; *(GAS v4u*)(WT + (size_t)(dstrow + n) * ldt + dstk + 8 * c) = (v4u){0u, 0u, 0u, 0u}; }
        return;
    }
#pragma unroll 8
    for (int i = 0; i < 32; ++i) { const int kk = 2 * i + (lane >> 5); float v = W[(size_t)(k0 + kk) * ldw + srccol + (lane & 31)]; if (gain) v *= gain[k0 + kk]; scr[kk * 33 + (lane & 31)] = v; }
    LDS_WAIT(); asm volatile("" ::: "memory");
    const int c = lane & 7;
#pragma unroll
    for (int j = 0; j < 4; ++j) { const int n = (lane >> 3) + 8 * j; const LAS float* s = scr + (8 * c) * 33 + n;
        v4u o; o.x = pk2(s[0 * 33], s[1 * 33]); o.y = pk2(s[2 * 33], s[3 * 33]); o.z = pk2(s[4 * 33], s[5 * 33]); o.w = pk2(s[6 * 33], s[7 * 33]);
        *(GAS v4u*)(WT + (size_t)(dstrow + n) * ldt + dstk + 8 * c) = o; }
    LDS_WAIT(); asm volatile("" ::: "memory");
}
constexpr int IT_IN = 32 * 256, IT_UQ = 8 * 48, IT_UKV = 4 * 64, IT_OD = 16 * 64, IT_OM = 16 * 64, IT_OUT = 32 * 64, IT_1 = 32 * 256, IT_2 = 128 * 64;
constexpr int IT_LAYER = IT_IN + IT_UQ + IT_UKV + IT_OD + IT_OM + IT_OUT + IT_1 + IT_2;

__device__ __forceinline__ void p0_weights(const Args& a, bf16* WB, LAS unsigned char* lds, int gw, int NGW, int wave, int lane) {
    LAS float* scr = (LAS float*)(lds + wave * 16384);
    for (int it = gw; it < DEPTH * IT_LAYER; it += NGW) {
        const int l = it / IT_LAYER; int r = it % IT_LAYER; bf16* Wl = WB + (size_t)l * W_LAYER;
        if (r < IT_IN) { const int kb = r / 256, nb = r % 256; const int src = nb < 122 ? nb * 32 : (nb < 128 ? -1 : (nb - 6) * 32);
            p0_item(a.w_in + (size_t)l * DM * 8000, 8000, kb * 64, src, Wl + W_IN, DM, nb * 32, kb * 64, nullptr, scr, lane); continue; } r -= IT_IN;
        if (r < IT_UQ) { const int kb = r / 48, nb = r % 48; const int src = nb < 32 ? (nb >> 2) * 192 + (nb & 3) * 32 : ((nb - 32) >> 1) * 192 + 128 + ((nb - 32) & 1) * 32;
            p0_item(a.w_uq + (size_t)l * 512 * 1536, 1536, kb * 64, src, Wl + W_UQ, 512, nb * 32, kb * 64, a.q_a_norm + l * 512, scr, lane); continue; } r -= IT_UQ;
        if (r < IT_UKV) { const int kb = r / 64, nb = r % 64; const int src = nb < 32 ? (nb >> 2) * 256 + (nb & 3) * 32 : ((nb - 32) >> 2) * 256 + 128 + ((nb - 32) & 3) * 32;
            p0_item(a.w_ukv + (size_t)l * 256 * 2048, 2048, kb * 64, src, Wl + W_UKV, 256, nb * 32, kb * 64, a.kv_a_norm + l * 256, scr, lane); continue; } r -= IT_UKV;
        if (r < IT_OD) { const int kb = r / 64, nb = r % 64; p0_item(a.w_o_diff + (size_t)l * 1024 * DM, DM, kb * 64, nb * 32, Wl + W_O, 2048, nb * 32, kb * 64, nullptr, scr, lane); continue; } r -= IT_OD;
        if (r < IT_OM) { const int kb = r / 64, nb = r % 64; p0_item(a.w_o_mla + (size_t)l * 1024 * DM, DM, kb * 64, nb * 32, Wl + W_O, 2048, nb * 32, 1024 + kb * 64, nullptr, scr, lane); continue; } r -= IT_OM;
        if (r < IT_OUT) { const int kb = r / 64, nb = r % 64; p0_item(a.w_out + (size_t)l * DM * DM, DM, kb * 64, nb * 32, Wl + W_OUT, DM, nb * 32, kb * 64, nullptr, scr, lane); continue; } r -= IT_OUT;
        if (r < IT_1) { const int kb = r / 256, nb = r % 256; p0_item(a.w_mlp1 + (size_t)l * DM * DFF, DFF, kb * 64, nb * 32, Wl + W_1, DM, nb * 32, kb * 64, nullptr, scr, lane); continue; } r -= IT_1;
        { const int kb = r / 64, nb = r % 64; p0_item(a.w_mlp2 + (size_t)l * DFF * DM, DM, kb * 64, nb * 32, Wl + W_2, DFF, nb * 32, kb * 64, nullptr, scr, lane); }
    }
}
__device__ __forceinline__ void p0_rope(float* rope, int gtid, int nthreads) {
    for (int e = gtid; e < SEQ * 32; e += nthreads) { const int t = e >> 5, i = e & 31; const float f = powf(10000.0f, -(float)(2 * (i & 15)) / 32.0f);
        const float ang = (float)((i < 16) ? (t >> 6) : (t & 63)) * f; rope[2 * e] = cosf(ang); rope[2 * e + 1] = sinf(ang); }
}
__device__ __forceinline__ void p0_mod(const Args& a, float* MOD, LAS unsigned char* lds, int vcu, int G, int tid, int wave, int lane) {
    LAS float* S = (LAS float*)lds;
    LAS float* P = (LAS float*)(lds + 17 * 2048 * 4);
    for (int e = tid; e < 17 * 2048; e += NWAVES * 64) { const float v = (e < 16 * 2048) ? a.c[e] : a.c_ctx[e - 16 * 2048]; S[e] = v / (1.0f + expf(-v)); }
    __syncthreads();
    for (int u = vcu; u < DEPTH * 192; u += G) {
        const int l = u / 192, col = (u % 192) * 64 + lane; const float* wp = a.w_ada + (size_t)l * DM * NMOD + col;
        float acc[17];
#pragma unroll
        for (int b = 0; b < 17; ++b) acc[b] = 0.f;
        for (int k = wave * 256; k < wave * 256 + 256; k += 4) {
            const float w0 = wp[(size_t)k * NMOD], w1 = wp[(size_t)(k + 1) * NMOD], w2 = wp[(size_t)(k + 2) * NMOD], w3 = wp[(size_t)(k + 3) * NMOD];
#pragma unroll
            for (int b = 0; b < 17; ++b) { const f32x4 s = *(const LAS f32x4*)(S + b * 2048 + k); acc[b] += (s[0] * w0 + s[1] * w1) + (s[2] * w2 + s[3] * w3); }
        }
        if (wave >= 4) {
#pragma unroll
            for (int b = 0; b < 17; ++b) P[((wave - 4) * 17 + b) * 64 + lane] = acc[b];
        }
        __syncthreads();
        if (wave < 4) {
#pragma unroll
            for (int b = 0; b < 17; ++b) { acc[b] += P[(wave * 17 + b) * 64 + lane]; P[(wave * 17 + b) * 64 + lane] = acc[b]; }
        }
        __syncthreads();
        if (wave == 0) { const float bias = a.b_ada[l * NMOD + col];
#pragma unroll
            for (int b = 0; b < 17; ++b) MOD[((size_t)l * 17 + b) * NMOD + col] = ((P[(0 * 17 + b) * 64 + lane] + P[(1 * 17 + b) * 64 + lane]) + (P[(2 * 17 + b) * 64 + lane] + P[(3 * 17 + b) * 64 + lane])) + bias;
        }
        __syncthreads();
    }
}
__device__ __forceinline__ void norm_mod_row(const float* xrow, const float* g, const float* shift, const float* scale, bf16* orow, int lane) {
    const GAS f32x4* xr = (const GAS f32x4*)xrow + lane; f32x4 v[8]; float s = 0.f;
#pragma unroll
    for (int j = 0; j < 8; ++j) { v[j] = xr[64 * j]; s += (v[j].x * v[j].x + v[j].y * v[j].y) + (v[j].z * v[j].z + v[j].w * v[j].w); }
    const float rstd = 1.0f / sqrtf(wave_sum(s) * (1.0f / DM) + EPS);
    GAS v2u* o8 = (GAS v2u*)orow + lane;
#pragma unroll
    for (int j = 0; j < 8; ++j) { const int c = 4 * (lane + 64 * j); const f32x4 gg = *(const f32x4*)(g + c), sh = *(const f32x4*)(shift + c), sc = *(const f32x4*)(scale + c);
        const f32x4 y = (v[j] * rstd) * gg * (sc + 1.0f) + sh; v2u w; w.x = pk2(y.x, y.y); w.y = pk2(y.z, y.w); o8[64 * j] = w; }
}
__device__ __forceinline__ void final_norm_row(float* xrow, const float* g, int lane) {
    GAS f32x4* xr = (GAS f32x4*)xrow + lane; f32x4 v[8]; float s = 0.f;
#pragma unroll
    for (int j = 0; j < 8; ++j) { v[j] = xr[64 * j]; s += (v[j].x * v[j].x + v[j].y * v[j].y) + (v[j].z * v[j].z + v[j].w * v[j].w); }
    const float rstd = 1.0f / sqrtf(wave_sum(s) * (1.0f / DM) + EPS);
#pragma unroll
    for (int j = 0; j < 8; ++j) { const f32x4 gg = *(const f32x4*)(g + 4 * (lane + 64 * j)); xr[64 * j] = (v[j] * rstd) * gg; }
}

__global__ void __launch_bounds__(NWAVES * 64, 2) mk_fwd(Args a) {
    extern __shared__ __attribute__((aligned(16))) unsigned char lds_raw[];
    LAS unsigned char* lds = (LAS unsigned char*)lds_raw;
    volatile LAS unsigned* MISC = (volatile LAS unsigned*)(lds + MISC_OFF);
    const int tid = threadIdx.x, lane = tid & 63, wave = __builtin_amdgcn_readfirstlane(tid >> 6);
    const int G = gridDim.x; const int bx = blockIdx.x; const int vcu = (G % 8 == 0) ? (bx % 8) * (G / 8) + bx / 8 : bx;
    const int gw = vcu * NWAVES + wave, NGW = G * NWAVES;
    unsigned char* ws = a.ws;
    gu32* ctl = (gu32*)(ws + WS_CTL);
    float* MOD = (float*)(ws + WS_MOD); float* ROPE = (float*)(ws + WS_ROPE); float* SSQ = (float*)(ws + WS_SSQ);
    bf16* WB = (bf16*)(ws + WS_W); float* XC = (float*)(ws + WS_XC); bf16* HB = (bf16*)(ws + WS_HB);
    unsigned char* big = ws + WS_BIG;
    bf16 *QD = (bf16*)(big + B_QD), *KD = (bf16*)(big + B_KD), *VD = (bf16*)(big + B_VD), *CQ = (bf16*)(big + B_CQ), *CKV = (bf16*)(big + B_CKV), *KR = (bf16*)(big + B_KR),
         *GT = (bf16*)(big + B_G), *QM = (bf16*)(big + B_QM), *KVM = (bf16*)(big + B_KVM), *MG = (bf16*)(big + B_MG), *UB = (bf16*)(big + B_U);
    for (int u = tid; u < 64; u += NWAVES * 64) MISC[u] = 0u;
    __syncthreads();
#if MK_MULTI
#define SEAM(k) do { } while (0)
#else
    XcdBarrier bar = xcd_barrier_post((unsigned*)(ctl + CW_BAR), MISC + 8);
#define SEAM(k) do { if ((k) + 1 < hi) xcd_barrier(bar); } while (0)
#endif
    const int lo = a.ph_lo, hi = a.ph_hi;
#define IN(k) (lo <= (k) && (k) < hi)
#define OPAQUE_IDS() int t_ = threadIdx.x; asm volatile("" : "+v"(t_)); const int lane_ = t_ & 63, gw_ = vcu * NWAVES + __builtin_amdgcn_readfirstlane(t_ >> 6); (void)lane_; (void)gw_
#ifndef MK_MASK
#define MK_MASK 0xFFFF
#endif
#define PH(i) if constexpr (((MK_MASK) >> (i)) & 1)

    PH(0) if (IN(0)) {
        p0_weights(a, WB, lds, gw, NGW, wave, lane);
        p0_rope(ROPE, vcu * NWAVES * 64 + tid, G * NWAVES * 64);
        __syncthreads();
        p0_mod(a, MOD, lds, vcu, G, tid, wave, lane);
        SEAM(0);
    }
    for (int l = 0; l < DEPTH; ++l) {
        const int pb = 1 + 9 * l;
        const bf16* Wl = WB + (size_t)l * W_LAYER;
        const float* modl = MOD + (size_t)l * 17 * NMOD;
        const float* xsrc = (l == 0) ? a.x : a.out;
        const float* csrc = (l == 0) ? a.ctx : XC;
        const bool lastl = (l == DEPTH - 1);
        const int Mact = lastl ? MLAT : MTOT;
        PH(1) if (IN(pb + 0)) {
            OPAQUE_IDS();
            for (int m = gw_; m < MTOT; m += NGW) {
                const bool lat = m < MLAT; const float* xr = lat ? xsrc + (size_t)m * DM : csrc + (size_t)(m - MLAT) * DM; const float* mr = modl + (size_t)(lat ? (m >> 11) : 16) * NMOD;
                norm_mod_row(xr, a.norm1_g + l * DM, mr, mr + DM, HB + (size_t)m * DM, lane_);
            }
            SEAM(pb + 0);
        }
        PH(2) if (IN(pb + 1)) {
            pg8::Gemm g{HB, Wl + W_IN, MTOT, NIN, DM}; pg8::StaticOrder S; S.init(MTOT, NIN, G, bx);
            pg8::EpiInProj E{QD, KD, VD, CQ, CKV, KR, GT, SSQ, a.b_gate + l * 4096, ROPE};
            pg8::gemm_phase<pg8::EpiInProj, pg8::StaticOrder, true, true>(lds, g, S, E);
            SEAM(pb + 1);
        }
        PH(3) if (IN(pb + 2)) {
            { pg8::Gemm g{CQ, Wl + W_UQ, MTOT, 1536, 512}; pg8::StaticOrder S; S.init(MTOT, 1536, G, bx);
              pg8::EpiUp<true> E{QM, SSQ, ROPE}; pg8::gemm_phase<pg8::EpiUp<true>, pg8::StaticOrder, true, true>(lds, g, S, E); }
            { pg8::Gemm g{CKV, Wl + W_UKV, MTOT, 2048, 256}; pg8::StaticOrder S; S.init(MTOT, 2048, G, bx);
              pg8::EpiUp<false> E{KVM, SSQ, ROPE}; pg8::gemm_phase<pg8::EpiUp<false>, pg8::StaticOrder, true, true>(lds, g, S, E); }
            SEAM(pb + 2);
        }
        PH(4) if (IN(pb + 3)) {
            OPAQUE_IDS();
            const float* dl = a.diff_lambda + l * 256;
            const float sa = wave_sum(dl[lane_] * dl[64 + lane_]), sb = wave_sum(dl[128 + lane_] * dl[192 + lane_]);
            const float lam_init = 0.8f - 0.6f * expf(-0.3f * (float)l);
            att::Args A{QD, KD, VD, QM, KVM, KR, HB, a.diff_subln + l * 128, expf(sa) - expf(sb) + lam_init, 1.0f - lam_init};
            const int n0 = lastl ? 2048 : 2048 + 256, n1 = lastl ? 1024 : 1024 + 128;
            for (int u = vcu; u < n0; u += G) { const bool isctx = u >= 2048; const int v = isctx ? u - 2048 : u; const int qb = isctx ? (v & 1) : (v & 15), bh = isctx ? (v >> 1) : (v >> 4);
                att::attn_unit<0>(A, bh >> 3, bh & 7, qb, isctx, (att::lptr)lds); }
            for (int u = vcu; u < n1; u += G) { const bool isctx = u >= 1024; const int v = isctx ? u - 1024 : u; const int qb = isctx ? 0 : (v & 7), bh = isctx ? v : (v >> 3);
                att::attn_unit<1>(A, bh >> 3, bh & 7, qb, isctx, (att::lptr)lds); }
            SEAM(pb + 3);
        }
        PH(5) if (IN(pb + 4)) {
            pg8::Gemm g{HB, Wl + W_O, Mact, DM, DM}; pg8::StaticOrder S; S.init(Mact, DM, G, bx);
            pg8::EpiMerge E{MG, GT}; pg8::gemm_phase<pg8::EpiMerge, pg8::StaticOrder, true, true>(lds, g, S, E);
            SEAM(pb + 4);
        }
        PH(6) if (IN(pb + 5)) {
            pg8::Gemm g{MG, Wl + W_OUT, Mact, DM, DM}; pg8::StaticOrder S; S.init(Mact, DM, G, bx);
            pg8::EpiResid E{a.out, xsrc, XC, csrc, modl + 2 * DM}; pg8::gemm_phase<pg8::EpiResid, pg8::StaticOrder, true, true>(lds, g, S, E);
            SEAM(pb + 5);
        }
        PH(7) if (IN(pb + 6)) {
            OPAQUE_IDS();
            for (int m = gw_; m < Mact; m += NGW) {
                const bool lat = m < MLAT; const float* xr = lat ? a.out + (size_t)m * DM : XC + (size_t)(m - MLAT) * DM; const float* mr = modl + (size_t)(lat ? (m >> 11) : 16) * NMOD;
                norm_mod_row(xr, a.norm2_g + l * DM, mr + 3 * DM, mr + 4 * DM, HB + (size_t)m * DM, lane_);
            }
            SEAM(pb + 6);
        }
        PH(8) if (IN(pb + 7)) {
            pg8::Gemm g{HB, Wl + W_1, Mact, DFF, DM}; pg8::StaticOrder S; S.init(Mact, DFF, G, bx);
            pg8::EpiRelu2 E{UB}; pg8::gemm_phase<pg8::EpiRelu2, pg8::StaticOrder, true, true>(lds, g, S, E);
            SEAM(pb + 7);
        }
        PH(9) if (IN(pb + 8)) {
            pg8::Gemm g{UB, Wl + W_2, Mact, DM, DFF}; pg8::StaticOrder S; S.init(Mact, DM, G, bx);
            pg8::EpiResid E{a.out, a.out, XC, XC, modl + 5 * DM}; pg8::gemm_phase<pg8::EpiResid, pg8::StaticOrder, true, true>(lds, g, S, E);
            SEAM(pb + 8);
        }
    }
    PH(10) if (IN(NPHASE - 1)) {
        OPAQUE_IDS();
        for (int m = gw_; m < MLAT; m += NGW) final_norm_row(a.out + (size_t)m * DM, a.final_norm_g, lane_);
    }
#undef IN
#undef SEAM
}
#if MK_DEBUG
constexpr int DBG_NS = 48;
__host__ __device__ inline int dbg_row(int s) { return (s * 577 + 13) % MTOT; }
__device__ inline void dbg_upd(float* err, float got, float ref, float sc) {
    float e = fabsf(got - ref) / (fabsf(ref) + sc); if (!(e == e) || !(got == got)) e = 1e9f;
    atomicMax((unsigned*)err, __float_as_uint(e));
}
__device__ inline float dbg_b(const bf16* p, size_t i) { return bf2f((unsigned)p[i]); }
__device__ inline void dbg_rope_cs(int t, int d, float& cs, float& sn) {
    const float f = powf(10000.0f, -(float)(2 * (d & 15)) / 32.0f); const float ang = (float)((d < 32) ? (t >> 6) : (t & 63)) * f; cs = cosf(ang); sn = sinf(ang);
}
struct DbgP { Args a; int l; int pad; float* err; };

__global__ void __launch_bounds__(256) dbg_mod(DbgP p) {
    const int l = blockIdx.x / 17, bb = blockIdx.x % 17, j = (threadIdx.x * 37 + 5) % NMOD; const float* cv = bb < 16 ? p.a.c + bb * DM : p.a.c_ctx;
    float acc = 0.f; for (int k = 0; k < DM; ++k) { const float v = cv[k]; acc += (v / (1.0f + expf(-v))) * p.a.w_ada[((size_t)l * DM + k) * NMOD + j]; }
    acc += p.a.b_ada[l * NMOD + j];
    dbg_upd(p.err, ((const float*)(p.a.ws + WS_MOD))[((size_t)l * 17 + bb) * NMOD + j], acc, 0.1f);
}
__global__ void __launch_bounds__(256) dbg_snap(const float* xs, const float* cs, float* snap) {
    const int m = dbg_row(blockIdx.x); const float* r = m < MLAT ? xs + (size_t)m * DM : cs + (size_t)(m - MLAT) * DM;
    for (int c = threadIdx.x; c < DM; c += 256) snap[(size_t)blockIdx.x * DM + c] = r[c];
}
__global__ void __launch_bounds__(256) dbg_norm(DbgP p, const float* xs, const float* cs, const float* g, int shoff, int scoff, int mact) {
    __shared__ float red[256];
    const int m = dbg_row(blockIdx.x); if (m >= mact) return; const float* r = m < MLAT ? xs + (size_t)m * DM : cs + (size_t)(m - MLAT) * DM;
    float s = 0.f; for (int c = threadIdx.x; c < DM; c += 256) s += r[c] * r[c];
    red[threadIdx.x] = s; __syncthreads(); for (int o = 128; o > 0; o >>= 1) { if ((int)threadIdx.x < o) red[threadIdx.x] += red[threadIdx.x + o]; __syncthreads(); }
    const float rstd = 1.0f / sqrtf(red[0] / DM + EPS); const float* mr = (const float*)(p.a.ws + WS_MOD) + ((size_t)p.l * 17 + (m < MLAT ? (m >> 11) : 16)) * NMOD;
    const bf16* H = (const bf16*)(p.a.ws + WS_HB);
    for (int c = threadIdx.x; c < DM; c += 256) { const float ref = r[c] * rstd * g[c] * (1.0f + mr[scoff + c]) + mr[shoff + c]; dbg_upd(p.err, dbg_b(H, (size_t)m * DM + c), ref, 0.5f); }
}
__global__ void __launch_bounds__(256) dbg_final(DbgP p, const float* snap) {
    __shared__ float red[256];
    const int m = dbg_row(blockIdx.x); if (m >= MLAT) return; const float* r = snap + (size_t)blockIdx.x * DM;
    float s = 0.f; for (int c = threadIdx.x; c < DM; c += 256) s += r[c] * r[c];
    red[threadIdx.x] = s; __syncthreads(); for (int o = 128; o > 0; o >>= 1) { if ((int)threadIdx.x < o) red[threadIdx.x] += red[threadIdx.x + o]; __syncthreads(); }
    const float rstd = 1.0f / sqrtf(red[0] / DM + EPS);
    for (int c = threadIdx.x; c < DM; c += 256) dbg_upd(p.err, p.a.out[(size_t)m * DM + c], r[c] * rstd * p.a.final_norm_g[c], 0.5f);
}
__global__ void __launch_bounds__(256) dbg_inproj(DbgP p) {
    const int m = dbg_row(blockIdx.y), n = blockIdx.x * 256 + threadIdx.x; if (n >= 8000) return;
    const bf16* H = (const bf16*)(p.a.ws + WS_HB) + (size_t)m * DM; const float* W = p.a.w_in + (size_t)p.l * DM * 8000;
    unsigned char* big = p.a.ws + WS_BIG; const bool lat = m < MLAT; const int t = m & 2047;
    int grp = -1, d = 0;
    if (n < 2048) { grp = 0; d = n & 63; } else if (n >= 3840 && n < 3904) { grp = 1; d = n - 3840; }
    const bool rot = (grp >= 0) && lat; const int np = rot ? (((d & 31) < 16) ? n + 16 : n - 16) : n;
    float acc = 0.f, accp = 0.f;
    for (int k = 0; k < DM; ++k) { const float h = bf2f((unsigned)H[k]); acc += h * W[(size_t)k * 8000 + n]; if (rot) accp += h * W[(size_t)k * 8000 + np]; }
    float v = acc;
    if (rot) { float cs, sn; dbg_rope_cs(t, d, cs, sn); v = acc * cs + (((d & 31) < 16) ? -accp : accp) * sn; }
    if (n < 1024) dbg_upd(p.err + 0, dbg_b((const bf16*)(big + B_QD), (size_t)m * 1024 + n), 0.125f * v, 0.06f);
    else if (n < 2048) dbg_upd(p.err + 1, dbg_b((const bf16*)(big + B_KD), (size_t)m * 1024 + n - 1024), v, 0.5f);
    else if (n < 3072) dbg_upd(p.err + 2, dbg_b((const bf16*)(big + B_VD), (size_t)m * 1024 + n - 2048), v, 0.5f);
    else if (n < 3584) dbg_upd(p.err + 3, dbg_b((const bf16*)(big + B_CQ), (size_t)m * 512 + n - 3072), v, 0.5f);
    else if (n < 3840) dbg_upd(p.err + 4, dbg_b((const bf16*)(big + B_CKV), (size_t)m * 256 + n - 3584), v, 0.5f);
    else if (n < 3904) dbg_upd(p.err + 5, dbg_b((const bf16*)(big + B_KR), (size_t)m * 64 + n - 3840), v, 0.5f);
    else dbg_upd(p.err + 6, dbg_b((const bf16*)(big + B_G), (size_t)m * 4096 + n - 3904), 1.0f / (1.0f + expf(-(v + p.a.b_gate[p.l * 4096 + n - 3904]))), 0.3f);
}
__global__ void __launch_bounds__(256) dbg_up(DbgP p) {
    __shared__ float red[256]; __shared__ float rs2[2];
    const int m = dbg_row(blockIdx.y); unsigned char* big = p.a.ws + WS_BIG; const bool lat = m < MLAT; const int t = m & 2047;
    const bf16* CQ = (const bf16*)(big + B_CQ) + (size_t)m * 512; const bf16* CKV = (const bf16*)(big + B_CKV) + (size_t)m * 256;
    { float s = 0.f; for (int k = threadIdx.x; k < 512; k += 256) { const float v = bf2f((unsigned)CQ[k]); s += v * v; }
      red[threadIdx.x] = s; __syncthreads(); for (int o = 128; o > 0; o >>= 1) { if ((int)threadIdx.x < o) red[threadIdx.x] += red[threadIdx.x + o]; __syncthreads(); }
      if (threadIdx.x == 0) rs2[0] = 1.0f / sqrtf(red[0] / 512.0f + EPS); __syncthreads();
      const float v = bf2f((unsigned)CKV[threadIdx.x]); red[threadIdx.x] = v * v; __syncthreads(); for (int o = 128; o > 0; o >>= 1) { if ((int)threadIdx.x < o) red[threadIdx.x] += red[threadIdx.x + o]; __syncthreads(); }
      if (threadIdx.x == 0) rs2[1] = 1.0f / sqrtf(red[0] / 256.0f + EPS); __syncthreads(); }
    const int n0 = blockIdx.x * 256 + threadIdx.x; if (n0 >= 3584) return;
    if (n0 < 1536) { const int n = n0, h = n / 192, j = n % 192; const float* W = p.a.w_uq + (size_t)p.l * 512 * 1536; const float* g = p.a.q_a_norm + p.l * 512;
        const bool rot = lat && j >= 128; const int d = j - 128; const int np = rot ? (((d & 31) < 16) ? n + 16 : n - 16) : n;
        float acc = 0.f, accp = 0.f; for (int k = 0; k < 512; ++k) { const float c = bf2f((unsigned)CQ[k]) * rs2[0] * g[k]; acc += c * W[(size_t)k * 1536 + n]; if (rot) accp += c * W[(size_t)k * 1536 + np]; }
        float v = acc; if (rot) { float cs, sn; dbg_rope_cs(t, d, cs, sn); v = acc * cs + (((d & 31) < 16) ? -accp : accp) * sn; }
        const size_t loc = (size_t)m * 1536 + (j < 128 ? h * 128 + j : 1024 + h * 64 + d);
        dbg_upd(p.err + (j < 128 ? 0 : 1), dbg_b((const bf16*)(big + B_QM), loc), v, 0.5f);
    } else { const int n = n0 - 1536, h = n / 256, j = n % 256; const float* W = p.a.w_ukv + (size_t)p.l * 256 * 2048; const float* g = p.a.kv_a_norm + p.l * 256;
        float acc = 0.f; for (int k = 0; k < 256; ++k) acc += bf2f((unsigned)CKV[k]) * rs2[1] * g[k] * W[(size_t)k * 2048 + n];
        const size_t loc = (size_t)m * 2048 + (j < 128 ? h * 128 + j : 1024 + h * 128 + (j - 128));
        dbg_upd(p.err + (j < 128 ? 2 : 3), dbg_b((const bf16*)(big + B_KVM), loc), acc, 0.5f);
    }
}
__global__ void __launch_bounds__(256) dbg_attn(DbgP p, int lastl) {
    __shared__ float s1[2304], s2[2304], red[256], q[256];
    const int m = dbg_row(blockIdx.y), h = blockIdx.x, tid = threadIdx.x; const bool lat = m < MLAT; if (!lat && lastl) return;
    unsigned char* big = p.a.ws + WS_BIG; const bf16 *QD = (const bf16*)(big + B_QD), *KD = (const bf16*)(big + B_KD), *VD = (const bf16*)(big + B_VD), *QM = (const bf16*)(big + B_QM), *KVM = (const bf16*)(big + B_KVM), *KR = (const bf16*)(big + B_KR);
    const bf16* Y = (const bf16*)(p.a.ws + WS_HB);
    const int b = lat ? (m >> 11) : ((m - MLAT) >> 8); const int nk = lat ? 2304 : 256;
    const float* dl = p.a.diff_lambda + p.l * 256; float sa = 0.f, sb = 0.f; for (int i = 0; i < 64; ++i) { sa += dl[i] * dl[64 + i]; sb += dl[128 + i] * dl[192 + i]; }
    const float lam_init = 0.8f - 0.6f * expf(-0.3f * (float)p.l), lam = expf(sa) - expf(sb) + lam_init;
#define DBG_KROW(k) ((k) < 256 ? MLAT + b * 256 + (k) : b * 2048 + (k) - 256)
#define DBG_BLOCKRED(OP, init) do { __syncthreads(); for (int o = 128; o > 0; o >>= 1) { if (tid < o) red[tid] = OP(red[tid], red[tid + o]); __syncthreads(); } } while (0)
    if (tid < 128) q[tid] = dbg_b(QD, (size_t)m * 1024 + h * 128 + tid);
    __syncthreads();
    for (int k = tid; k < nk; k += 256) { const size_t kr = (size_t)DBG_KROW(k) * 1024 + h * 128; float a1 = 0.f, a2 = 0.f;
        for (int d = 0; d < 64; ++d) { a1 += q[d] * dbg_b(KD, kr + d); a2 += q[64 + d] * dbg_b(KD, kr + 64 + d); } s1[k] = a1; s2[k] = a2; }
    __syncthreads();
#define DBG_ADD(x, y) ((x) + (y))
#define DBG_SOFTPV(sc, outv) do { float mx = -1e30f; for (int k = tid; k < nk; k += 256) mx = fmaxf(mx, sc[k]); red[tid] = mx; DBG_BLOCKRED(fmaxf, 0); mx = red[0]; __syncthreads(); \
        float sm = 0.f; for (int k = tid; k < nk; k += 256) { const float e = expf(sc[k] - mx); sc[k] = e; sm += e; } red[tid] = sm; \
        DBG_BLOCKRED(DBG_ADD, 0); sm = red[0]; __syncthreads(); \
        if (tid < 128) { float o = 0.f; for (int k = 0; k < nk; ++k) o += sc[k] * dbg_b(VD, (size_t)DBG_KROW(k) * 1024 + h * 128 + tid); outv = o / sm; } \
        __syncthreads(); } while (0)
    float o1 = 0.f, o2 = 0.f;
    DBG_SOFTPV(s1, o1); DBG_SOFTPV(s2, o2);
    { const float y = o1 - lam * o2; red[tid] = (tid < 128) ? y * y : 0.f; DBG_BLOCKRED(DBG_ADD, 0); const float rs = 1.0f / sqrtf(red[0] / 128.0f + EPS); __syncthreads();
      if (tid < 128) dbg_upd(p.err, dbg_b(Y, (size_t)m * 2048 + h * 128 + tid), y * rs * p.a.diff_subln[p.l * 128 + tid] * (1.0f - lam_init), 0.3f); }
    __syncthreads();
    if (tid < 128) q[tid] = dbg_b(QM, (size_t)m * 1536 + h * 128 + tid); else if (tid < 192) q[tid] = dbg_b(QM, (size_t)m * 1536 + 1024 + h * 64 + (tid - 128));
    __syncthreads();
    for (int k = tid; k < nk; k += 256) { const int kr = DBG_KROW(k); float a1 = 0.f;
        for (int d = 0; d < 128; ++d) a1 += q[d] * dbg_b(KVM, (size_t)kr * 2048 + h * 128 + d);
        for (int d = 0; d < 64; ++d) a1 += q[128 + d] * dbg_b(KR, (size_t)kr * 64 + d);
        s1[k] = a1 * MLA_SCALE; }
    __syncthreads();
    { float mx = -1e30f; for (int k = tid; k < nk; k += 256) mx = fmaxf(mx, s1[k]); red[tid] = mx; DBG_BLOCKRED(fmaxf, 0); mx = red[0]; __syncthreads();
      float sm = 0.f; for (int k = tid; k < nk; k += 256) { const float e = expf(s1[k] - mx); s1[k] = e; sm += e; } red[tid] = sm; DBG_BLOCKRED(DBG_ADD, 0); sm = red[0]; __syncthreads();
      if (tid < 128) { float o = 0.f; for (int k = 0; k < nk; ++k) o += s1[k] * dbg_b(KVM, (size_t)DBG_KROW(k) * 2048 + 1024 + h * 128 + tid);
          dbg_upd(p.err + 1, dbg_b(Y, (size_t)m * 2048 + 1024 + h * 128 + tid), o / sm, 0.02f); } }
}
__global__ void __launch_bounds__(256) dbg_merge(DbgP p, int mact) {
    const int m = dbg_row(blockIdx.y), n = blockIdx.x * 256 + threadIdx.x; if (m >= mact) return;
    const bf16* Y = (const bf16*)(p.a.ws + WS_HB) + (size_t)m * 2048; const bf16* G = (const bf16*)(p.a.ws + WS_BIG + B_G) + (size_t)m * 4096;
    const float* Wd = p.a.w_o_diff + (size_t)p.l * 1024 * DM; const float* Wm = p.a.w_o_mla + (size_t)p.l * 1024 * DM;
    float a1 = 0.f, a2 = 0.f; for (int k = 0; k < 1024; ++k) { a1 += bf2f((unsigned)Y[k]) * Wd[(size_t)k * DM + n]; a2 += bf2f((unsigned)Y[1024 + k]) * Wm[(size_t)k * DM + n]; }
    const float got = dbg_b((const bf16*)(p.a.ws + WS_BIG + B_MG), (size_t)m * 2048 + n), gd = bf2f((unsigned)G[n]), gm = bf2f((unsigned)G[2048 + n]);
    dbg_upd(p.err + 0, got, gd * a1 + gm * a2, 0.5f);
}
__global__ void __launch_bounds__(256) dbg_resid(DbgP p, const bf16* A, int K, const float* W, int goff, const float* snap, int mact) {
    const int m = dbg_row(blockIdx.y), n = blockIdx.x * 256 + threadIdx.x; if (m >= mact) return;
    float acc = 0.f; for (int k = 0; k < K; ++k) acc += bf2f((unsigned)A[(size_t)m * K + k]) * W[(size_t)k * DM + n];
    const float g = ((const float*)(p.a.ws + WS_MOD))[((size_t)p.l * 17 + (m < MLAT ? (m >> 11) : 16)) * NMOD + goff + n];
    const float got = m < MLAT ? p.a.out[(size_t)m * DM + n] : ((const float*)(p.a.ws + WS_XC))[(size_t)(m - MLAT) * DM + n];
    dbg_upd(p.err, got, snap[(size_t)blockIdx.y * DM + n] + g * acc, 0.5f);
}
__global__ void __launch_bounds__(256) dbg_mlp1(DbgP p, int mact) {
    const int m = dbg_row(blockIdx.y), n = blockIdx.x * 256 + threadIdx.x; if (m >= mact) return;
    const bf16* H = (const bf16*)(p.a.ws + WS_HB) + (size_t)m * DM; const float* W = p.a.w_mlp1 + (size_t)p.l * DM * DFF;
    float acc = 0.f; for (int k = 0; k < DM; ++k) acc += bf2f((unsigned)H[k]) * W[(size_t)k * DFF + n];
    acc = fmaxf(acc, 0.f); dbg_upd(p.err, dbg_b((const bf16*)(p.a.ws + WS_BIG + B_U), (size_t)m * DFF + n), acc * acc, 0.5f);
}
__global__ void __launch_bounds__(256) dbg_report(const float* err, float* out, int n) {
    int kf = -1;
    for (int k = 0; k < 96; ++k) { if (err[k] > 0.03f) { kf = k; break; } }
    if (kf < 0) return;
    if (kf == 40) {
        int hp = -1; for (int k = 41; k < 47; ++k) if (err[k] <= 0.03f) { hp = k; break; }
        const float f = hp >= 0 ? 0.5f : fminf(1.0f, err[40]); const size_t lim = (size_t)((double)f * (double)n); const float cval = 100.0f * (float)((hp >= 0 ? hp : 40) + 1);
        for (size_t i = (size_t)blockIdx.x * 256 + threadIdx.x; i < (size_t)n; i += (size_t)gridDim.x * 256) out[i] = (i < lim) ? cval : 0.0f;
        return;
    }
    int nf = 0; for (int k = (kf & ~7); k < (kf & ~7) + 8; ++k) nf += (err[k] > 0.03f) ? 1 : 0;
    const size_t lim = (size_t)n / 8 * (size_t)nf;
    for (size_t i = (size_t)blockIdx.x * 256 + threadIdx.x; i < (size_t)n; i += (size_t)gridDim.x * 256) out[i] = (i < lim) ? 100.0f * (float)(kf + 1) : 0.0f;
}
#ifndef DBG_LAYER
#define DBG_LAYER 0
#endif
static void dbg_pre(const Args& a, int ph, hipStream_t st) {
    float* snap = (float*)(a.ws + WS_SNAP);
    if (ph == NPHASE - 1) { hipLaunchKernelGGL(dbg_snap, dim3(DBG_NS), dim3(256), 0, st, (const float*)a.out, (const float*)(a.ws + WS_XC), snap); return; }
    if (ph < 1) return; const int l = (ph - 1) / 9, k = (ph - 1) % 9; if (l != DBG_LAYER) return;
    if (k == 5) hipLaunchKernelGGL(dbg_snap, dim3(DBG_NS), dim3(256), 0, st, l == 0 ? a.x : (const float*)a.out, l == 0 ? a.ctx : (const float*)(a.ws + WS_XC), snap);
    if (k == 8) hipLaunchKernelGGL(dbg_snap, dim3(DBG_NS), dim3(256), 0, st, (const float*)a.out, (const float*)(a.ws + WS_XC), snap);
}
static void dbg_post(const Args& a, int ph, hipStream_t st) {
    float* errb = (float*)(a.ws + WS_CTL) + CW_ERR; float* snap = (float*)(a.ws + WS_SNAP);
    if (ph == 0) { DbgP p{a, 0, 0, errb + 0}; hipLaunchKernelGGL(dbg_mod, dim3(DEPTH * 17), dim3(256), 0, st, p); return; }
    if (ph == NPHASE - 1) { DbgP p{a, 0, 0, errb + 80}; hipLaunchKernelGGL(dbg_final, dim3(DBG_NS), dim3(256), 0, st, p, (const float*)snap); return; }
    const int l = (ph - 1) / 9, k = (ph - 1) % 9; if (l != DBG_LAYER) return; const bool lastl = l == DEPTH - 1; const int mact = lastl ? MLAT : MTOT; float* e = errb + 8 * (k + 1);
    const float* xs = l == 0 ? a.x : (const float*)a.out; const float* cs = l == 0 ? a.ctx : (const float*)(a.ws + WS_XC);
    DbgP p{a, l, 0, e};
    if (k == 0) hipLaunchKernelGGL(dbg_norm, dim3(DBG_NS), dim3(256), 0, st, p, xs, cs, a.norm1_g + l * DM, 0, DM, MTOT);
    if (k == 1) hipLaunchKernelGGL(dbg_inproj, dim3(32, DBG_NS), dim3(256), 0, st, p);
    if (k == 2) hipLaunchKernelGGL(dbg_up, dim3(14, DBG_NS), dim3(256), 0, st, p);
    if (k == 3) hipLaunchKernelGGL(dbg_attn, dim3(8, DBG_NS), dim3(256), 0, st, p, lastl ? 1 : 0);
    if (k == 4) hipLaunchKernelGGL(dbg_merge, dim3(8, DBG_NS), dim3(256), 0, st, p, mact);
    if (k == 5) hipLaunchKernelGGL(dbg_resid, dim3(8, DBG_NS), dim3(256), 0, st, p, (const bf16*)(a.ws + WS_BIG + B_MG), DM, a.w_out + (size_t)l * DM * DM, 2 * DM, (const float*)snap, mact);
    if (k == 6) hipLaunchKernelGGL(dbg_norm, dim3(DBG_NS), dim3(256), 0, st, p, (const float*)a.out, (const float*)(a.ws + WS_XC), a.norm2_g + l * DM, 3 * DM, 4 * DM, mact);
    if (k == 7) hipLaunchKernelGGL(dbg_mlp1, dim3(32, DBG_NS), dim3(256), 0, st, p, mact);
    if (k == 8) hipLaunchKernelGGL(dbg_resid, dim3(8, DBG_NS), dim3(256), 0, st, p, (const bf16*)(a.ws + WS_BIG + B_U), DFF, a.w_mlp2 + (size_t)l * DFF * DM, 5 * DM, (const float*)snap, mact);
}
#endif
extern "C" void kernel_launch(void* const* d_in, const int* in_sizes, int n_in, void* d_out, int out_size, void* d_ws, size_t ws_size, hipStream_t stream) {
    static int grid = 0;
    if (grid == 0) {
        if (n_in != 22 || in_sizes[0] != MLAT * DM || out_size != MLAT * DM || ws_size < WS_END) {
            fprintf(stderr, "kernel_launch: shape mismatch (n_in %d, in0 %d, out %d, ws %zu; need ws >= %zu); nothing launched\n", n_in, n_in > 0 ? in_sizes[0] : -1, out_size, ws_size, (size_t)WS_END); grid = -1; return; }
        int dev = 0, cus = 0, per_cu = 0;
        if (hipGetDevice(&dev) != hipSuccess || hipDeviceGetAttribute(&cus, hipDeviceAttributeMultiprocessorCount, dev) != hipSuccess) { fprintf(stderr, "kernel_launch: device query failed\n"); grid = -1; return; }
        if (hipFuncSetAttribute((const void*)mk_fwd, hipFuncAttributeMaxDynamicSharedMemorySize, LDS_BYTES) != hipSuccess) { fprintf(stderr, "kernel_launch: hipFuncSetAttribute failed\n"); grid = -1; return; }
        if (hipOccupancyMaxActiveBlocksPerMultiprocessor(&per_cu, (const void*)mk_fwd, NWAVES * 64, LDS_BYTES) != hipSuccess || per_cu < 1)
            fprintf(stderr, "kernel_launch: note: occupancy query reports %d workgroups per CU\n", per_cu);
        (void)hipGetLastError();
        grid = cus;
        if (grid > 256) grid = 256;
    }
    if (grid < 0) return;
    if (hipMemsetAsync((char*)d_ws + WS_CTL, 0, CTL_ZERO_BYTES, stream) != hipSuccess) { fprintf(stderr, "kernel_launch: memset failed\n"); return; }
    Args a{};
    a.x = (const float*)d_in[0]; a.c = (const float*)d_in[1]; a.ctx = (const float*)d_in[2]; a.c_ctx = (const float*)d_in[3]; a.w_ada = (const float*)d_in[4]; a.b_ada = (const float*)d_in[5];
    a.norm1_g = (const float*)d_in[6]; a.norm2_g = (const float*)d_in[7]; a.w_in = (const float*)d_in[8]; a.b_gate = (const float*)d_in[9]; a.q_a_norm = (const float*)d_in[10];
    a.w_uq = (const float*)d_in[11]; a.kv_a_norm = (const float*)d_in[12]; a.w_ukv = (const float*)d_in[13]; a.diff_lambda = (const float*)d_in[14]; a.diff_subln = (const float*)d_in[15];
    a.w_o_diff = (const float*)d_in[16]; a.w_o_mla = (const float*)d_in[17]; a.w_out = (const float*)d_in[18]; a.w_mlp1 = (const float*)d_in[19]; a.w_mlp2 = (const float*)d_in[20];
    a.final_norm_g = (const float*)d_in[21];
    a.out = (float*)d_out; a.ws = (unsigned char*)d_ws;
#if MK_MULTI
    for (int p = 0; p < NPHASE; ++p) {
        a.ph_lo = p; a.ph_hi = p + 1;
#if MK_DEBUG
        dbg_pre(a, p, stream);
#endif
        hipLaunchKernelGGL(mk_fwd, dim3(grid), dim3(NWAVES * 64), LDS_BYTES, stream, a);
#if MK_DEBUG
        dbg_post(a, p, stream);
#endif
    }
#if MK_DEBUG
    hipLaunchKernelGGL(dbg_report, dim3(1024), dim3(256), 0, stream, (const float*)((char*)d_ws + WS_CTL) + CW_ERR, (float*)d_out, out_size);
#endif
#else
    a.ph_lo = 0; a.ph_hi = NPHASE;
    hipLaunchKernelGGL(mk_fwd, dim3(grid), dim3(NWAVES * 64), LDS_BYTES, stream, a);
#endif
    const hipError_t le = hipPeekAtLastError();
    if (le != hipSuccess) fprintf(stderr, "kernel_launch: launch failed: %s\n", hipGetErrorName(le));
}
```

```cpp
#include <hip/hip_runtime.h>
#include <cstdio>
#include <cstdint>

#ifndef MK_DEBUG
#define MK_DEBUG 0
#endif
#ifndef MK_MULTI
#define MK_MULTI 0
#endif

constexpr int DM = 2048, NBATCH = 16, SEQ = 2048, DEPTH = 4, CTXL = 256, DFF = 8192;
constexpr int MLAT = NBATCH * SEQ;
constexpr int MCTX = NBATCH * CTXL;
constexpr int MTOT = MLAT + MCTX;
constexpr int NIN = 8192;
constexpr int NMOD = 6 * DM;
constexpr float EPS = 1e-6f;
constexpr float MLA_SCALE = 0.07216878364870322f;
constexpr float LOG2E = 1.4426950408889634f;

constexpr size_t MiB = 1u << 20;
constexpr size_t WS_CTL = 0, CTL_ZERO_BYTES = 1 * MiB;
constexpr size_t WS_MOD = 1 * MiB;
constexpr size_t WS_ROPE = 5 * MiB;
constexpr size_t WS_SSQ = 6 * MiB;
constexpr size_t WS_W = 8 * MiB;
constexpr size_t W_IN = 0, W_UQ = W_IN + (size_t)NIN * DM, W_UKV = W_UQ + (size_t)1536 * 512, W_O = W_UKV + (size_t)2048 * 256,
                 W_OUT = W_O + (size_t)DM * DM, W_1 = W_OUT + (size_t)DM * DM, W_2 = W_1 + (size_t)DFF * DM, W_LAYER = W_2 + (size_t)DM * DFF;
constexpr size_t WS_XC = WS_W + ((DEPTH * W_LAYER * 2 + MiB - 1) / MiB) * MiB;
constexpr size_t WS_HB = WS_XC + (size_t)MCTX * DM * 4;
constexpr size_t WS_BIG = WS_HB + (size_t)MTOT * DM * 2;
constexpr size_t B_QD = 0, B_KD = B_QD + (size_t)MTOT * 1024 * 2, B_VD = B_KD + (size_t)MTOT * 1024 * 2, B_CQ = B_VD + (size_t)MTOT * 1024 * 2,
                 B_CKV = B_CQ + (size_t)MTOT * 512 * 2, B_KR = B_CKV + (size_t)MTOT * 256 * 2, B_G = B_KR + (size_t)MTOT * 64 * 2,
                 B_QM = B_G + (size_t)MTOT * 4096 * 2, B_KVM = B_QM + (size_t)MTOT * 1536 * 2, B_END = B_KVM + (size_t)MTOT * 2048 * 2;
constexpr size_t B_MG = 0;
constexpr size_t B_U = 0;
static_assert(B_KD + (size_t)MTOT * 1024 * 2 == (size_t)MTOT * 2048 * 2, "MG overlays exactly QD|KD");
static_assert((size_t)MTOT * DFF * 2 <= B_END, "U fits in BIG");
constexpr size_t WS_PART = WS_BIG + B_END;
constexpr size_t WS_SNAP = WS_PART + 2 * (size_t)MCTX * DM * 4;
constexpr size_t WS_END = WS_SNAP + 2 * MiB;
static_assert(WS_END < 1600000000ull, "workspace budget");

constexpr int CW_TMO = 0, CW_CODE = 1;
constexpr int CW_ERR = 64;
constexpr int CW_BAR = 4096;

constexpr int LDS_BYTES = 163840;
constexpr int RING_BYTES = 131072;
constexpr int MISC_OFF = LDS_BYTES - 256;

#define GAS __attribute__((address_space(1)))
#define LAS __attribute__((address_space(3)))
typedef unsigned short bf16;
typedef unsigned v4u __attribute__((ext_vector_type(4)));
typedef unsigned v2u __attribute__((ext_vector_type(2)));
typedef float f32x4 __attribute__((ext_vector_type(4)));
typedef float f32x2 __attribute__((ext_vector_type(2)));
typedef GAS unsigned gu32;
#define RLX_AGENT __ATOMIC_RELAXED, __HIP_MEMORY_SCOPE_AGENT
#define LDS_WAIT() asm volatile("s_waitcnt lgkmcnt(0)" ::: "memory")
#define VM_WAIT() asm volatile("s_waitcnt vmcnt(0)" ::: "memory")
__device__ __forceinline__ unsigned f2bf(float f) { unsigned u = __builtin_bit_cast(unsigned, f); return (u + 0x7fffu + ((u >> 16) & 1u)) >> 16; }
__device__ __forceinline__ unsigned pk2(float lo, float hi) { return f2bf(lo) | (f2bf(hi) << 16); }
__device__ __forceinline__ float bf2f(unsigned h) { return __builtin_bit_cast(float, h << 16); }
__device__ __forceinline__ float bflo(unsigned w) { return __builtin_bit_cast(float, w << 16); }
__device__ __forceinline__ float bfhi(unsigned w) { return __builtin_bit_cast(float, w & 0xffff0000u); }
__device__ __forceinline__ float wave_sum(float v) {
#pragma unroll
    for (int o = 1; o < 64; o <<= 1) v += __shfl_xor(v, o);
    return v;
}
namespace pg8 {
#define PG8_LAS __attribute__((address_space(3)))
typedef unsigned short bf16_t;
typedef short bf16x8 __attribute__((ext_vector_type(8)));
typedef float f32x4 __attribute__((ext_vector_type(4)));
typedef unsigned u32x4 __attribute__((ext_vector_type(4)));
constexpr int BM = 256, BK = 64, HALF = 128, HTB = HALF * BK * 2  , STAGE_BYTES = 8 * HTB, NXCD = 8, WGM = 8;

__host__ __device__ __forceinline__ int lds_byte(int r, int c) { const int st = (r >> 4) * 2 + (c >> 5), rr = r & 15, cc = c & 31, ob = rr * 64 + cc * 2; return st * 1024 + (ob ^ (((ob >> 9) & 1) << 5)); }
__host__ __device__ __forceinline__ void stage_rc(int b, int& R, int& C) { const int st = b / 1024, sb = b % 1024, swz = sb ^ (((sb >> 9) & 1) << 5); R = (st >> 1) * 16 + swz / 64; C = (st & 1) * 32 + (swz % 64) / 2; }
__host__ __device__ __forceinline__ int perm32(int rho) { const int n = rho >> 4, i = rho & 15; return 8 * (i >> 2) + 4 * n + (i & 3); }

struct Unit { int pm, pn, kt0, cnt; };
struct Gemm { const bf16_t* A; const bf16_t* Bt; int M, N, K; };

struct StaticOrder {
    int nM, nN, nwg, G, c;
    __host__ __device__ void init(int M, int N, int G_, int c_) { nM = M / BM; nN = N / BM; nwg = nM * nN; G = G_; c = c_; }
    __host__ __device__ bool next(int i, Unit& u) const {
        const long L = (long)i * G + c; if (L >= nwg) return false;
        int wgid = (int)L; { const int q = nwg / NXCD, r = nwg % NXCD, xcd = wgid % NXCD, off = wgid / NXCD; wgid = (xcd < r ? xcd * (q + 1) : r * (q + 1) + (xcd - r) * q) + off; }
        const int nig = WGM * nN, gid = wgid / nig, fm = gid * WGM, gsz = (nM - fm) < WGM ? (nM - fm) : WGM;
        u.pm = fm + ((wgid % nig) % gsz); u.pn = (wgid % nig) / gsz; u.kt0 = 0; u.cnt = 0; return true;
    }
    __device__ __forceinline__ void a_ready(const Unit&) const {}
    __device__ __forceinline__ void done(const Unit&) const {}
};


struct TailSplitOrder {
    StaticOrder so; int nmain, ntail2, ntr, pm0, ntk, G, c;
    __host__ __device__ void init(int M_main, int M_total, int N, int K, int G_, int c_) { so.init(M_main, N, G_, c_); nmain = so.nwg; ntr = (M_total - M_main) / BM; ntail2 = 2 * ntr * (N / BM); pm0 = M_main / BM; ntk = K / BK; G = G_; c = c_; }
    __host__ __device__ bool next(int i, Unit& u) const {
        const long L = (long)i * G + c; if (L < nmain) return so.next(i, u);
        const int j = (int)(L - nmain); if (j >= ntail2) return false;
        const int tile = j >> 1; u.pm = pm0 + tile % ntr; u.pn = tile / ntr; u.kt0 = (j & 1) * (ntk >> 1); u.cnt = ntk >> 1; return true;
    }
    __device__ __forceinline__ void a_ready(const Unit&) const {}
    __device__ __forceinline__ void done(const Unit&) const {}
};
typedef float cvt_f32x2_t __attribute__((ext_vector_type(2))); typedef __bf16 cvt_bf16x2_t __attribute__((ext_vector_type(2)));
__device__ __forceinline__ unsigned cvt_pk_bf16(float lo, float hi) { cvt_f32x2_t v = {lo, hi}; cvt_bf16x2_t b = __builtin_convertvector(v, cvt_bf16x2_t); return __builtin_bit_cast(unsigned, b); }
typedef float f32x2 __attribute__((ext_vector_type(2)));
__device__ __forceinline__ void st8(bf16_t* p, const f32x4 a, const f32x4 b) {
    u32x4 w; w.x = cvt_pk_bf16(a[0], a[1]); w.y = cvt_pk_bf16(a[2], a[3]); w.z = cvt_pk_bf16(b[0], b[1]); w.w = cvt_pk_bf16(b[2], b[3]); *(u32x4*)p = w;
}
__device__ __forceinline__ float blo(unsigned w) { return __builtin_bit_cast(float, w << 16); }
__device__ __forceinline__ float bhi(unsigned w) { return __builtin_bit_cast(float, w & 0xffff0000u); }
__device__ __forceinline__ void rope8(f32x4& a, f32x4& b, const float* rp, bool first_half) {
    const f32x4 t0 = *(const f32x4*)(rp), t1 = *(const f32x4*)(rp + 4), t2 = *(const f32x4*)(rp + 8), t3 = *(const f32x4*)(rp + 12);
    f32x4 pa, pb;
#pragma unroll
    for (int e = 0; e < 4; ++e) { pa[e] = __shfl_xor(a[e], 32); pb[e] = __shfl_xor(b[e], 32); }
    const float sg = first_half ? -1.f : 1.f;
    a[0] = a[0] * t0[0] + sg * pa[0] * t0[1]; a[1] = a[1] * t0[2] + sg * pa[1] * t0[3];
    a[2] = a[2] * t1[0] + sg * pa[2] * t1[1]; a[3] = a[3] * t1[2] + sg * pa[3] * t1[3];
    b[0] = b[0] * t2[0] + sg * pb[0] * t2[1]; b[1] = b[1] * t2[2] + sg * pb[1] * t2[3];
    b[2] = b[2] * t3[0] + sg * pb[2] * t3[1]; b[3] = b[3] * t3[2] + sg * pb[3] * t3[3];
}

struct EpiInProj {
    static constexpr bool PERM = true, AFTER_DRAIN = false, MIDHOOK = false;
    bf16_t *QD, *KD, *VD, *CQ, *CKV, *KR, *G; float* SSQ; const float* bgate; const float* rope;
    __device__ __forceinline__ void operator()(const f32x4 (&acc)[2][2][4][2], const Unit& u, int wr, int wc, int fr, int fq) const {
        const int pn = u.pn, cw = wc * 32 + 8 * fq; int rowb = u.pm * BM + wr * 64 + fr; asm volatile("" : "+v"(rowb)); const bool lat = u.pm < 128;
        const int ridx = (16 * (wc & 1) + 8 * (fq & 1)) * 2;
        if (pn < 8) {
            bf16_t* dst = (pn < 4) ? QD : KD; const int colt = (pn & 3) * 256; const float sc = (pn < 4) ? 0.125f : 1.0f;
#pragma unroll
            for (int ai = 0; ai < 2; ++ai)
#pragma unroll
                for (int m = 0; m < 4; ++m) { const int row = rowb + ai * HALF + m * 16; const float* rp = rope + (size_t)(row & 2047) * 64 + ridx;
#pragma unroll
                    for (int bj = 0; bj < 2; ++bj) { f32x4 a = acc[ai][bj][m][0], b = acc[ai][bj][m][1];
                        if (lat) rope8(a, b, rp, fq < 2);
                        st8(dst + (size_t)row * 1024 + colt + bj * HALF + cw, a * sc, b * sc); }
                    asm volatile("" ::: "memory"); }
        } else if (pn < 12) {
            const int colt = (pn - 8) * 256;
#pragma unroll
            for (int ai = 0; ai < 2; ++ai)
#pragma unroll
                for (int m = 0; m < 4; ++m) { const int row = rowb + ai * HALF + m * 16;
#pragma unroll
                    for (int bj = 0; bj < 2; ++bj) st8(VD + (size_t)row * 1024 + colt + bj * HALF + cw, acc[ai][bj][m][0], acc[ai][bj][m][1]); }
        } else if (pn < 15) {
            bf16_t* dst = (pn < 14) ? CQ : CKV; const int ld = (pn < 14) ? 512 : 256, colt = (pn == 13) ? 256 : 0, slot = (pn - 12) * 4 + wc;
#pragma unroll
            for (int ai = 0; ai < 2; ++ai)
#pragma unroll
                for (int m = 0; m < 4; ++m) { const int row = rowb + ai * HALF + m * 16; float s = 0.f;
#pragma unroll
                    for (int bj = 0; bj < 2; ++bj) { const f32x4 a = acc[ai][bj][m][0], b = acc[ai][bj][m][1];
                        s += (a[0] * a[0] + a[1] * a[1]) + (a[2] * a[2] + a[3] * a[3]) + (b[0] * b[0] + b[1] * b[1]) + (b[2] * b[2] + b[3] * b[3]);
                        st8(dst + (size_t)row * ld + colt + bj * HALF + cw, a, b); }
                    s += __shfl_xor(s, 16); s += __shfl_xor(s, 32);
                    if (fq == 0) SSQ[(size_t)row * 12 + slot] = s; }
        } else if (pn == 15) {
#pragma unroll
            for (int ai = 0; ai < 2; ++ai)
#pragma unroll
                for (int m = 0; m < 4; ++m) { const int row = rowb + ai * HALF + m * 16; const float* rp = rope + (size_t)(row & 2047) * 64 + ridx;
                    f32x4 a = acc[ai][0][m][0], b = acc[ai][0][m][1];
                    if (lat) rope8(a, b, rp, fq < 2);
                    if (wc < 2) st8(KR + (size_t)row * 64 + cw, a, b); }
        } else {
            const int colt = (pn - 16) * 256;
            f32x4 bv[2][2];
#pragma unroll
            for (int bj = 0; bj < 2; ++bj)
#pragma unroll
                for (int n = 0; n < 2; ++n) bv[bj][n] = *(const f32x4*)(bgate + colt + bj * HALF + cw + 4 * n);
#pragma unroll
            for (int ai = 0; ai < 2; ++ai)
#pragma unroll
                for (int m = 0; m < 4; ++m) { const int row = rowb + ai * HALF + m * 16;
#pragma unroll
                    for (int bj = 0; bj < 2; ++bj) { f32x4 v[2];
#pragma unroll
                        for (int n = 0; n < 2; ++n) { const f32x4 z = acc[ai][bj][m][n] + bv[bj][n];
#pragma unroll
                            for (int e = 0; e < 4; ++e) v[n][e] = __builtin_amdgcn_rcpf(1.0f + __expf(-z[e])); }
                        st8(G + (size_t)row * 4096 + colt + bj * HALF + cw, v[0], v[1]); } }
        }
    }
};

template <bool ISQ> struct EpiUp {
    static constexpr bool PERM = true, AFTER_DRAIN = false, MIDHOOK = false;
    bf16_t* O; const float* SSQ; const float* rope;
    __device__ __forceinline__ void operator()(const f32x4 (&acc)[2][2][4][2], const Unit& u, int wr, int wc, int fr, int fq) const {
        const int pn = u.pn, cw = wc * 32 + 8 * fq; int rowb = u.pm * BM + wr * 64 + fr; asm volatile("" : "+v"(rowb)); const bool lat = u.pm < 128;
        const int ridx = (16 * (wc & 1) + 8 * (fq & 1)) * 2; constexpr int ld = ISQ ? 1536 : 2048; const bool dorope = ISQ && pn >= 4 && lat;
#pragma unroll
        for (int ai = 0; ai < 2; ++ai)
#pragma unroll
            for (int m = 0; m < 4; ++m) { const int row = rowb + ai * HALF + m * 16; const float* sp = SSQ + (size_t)row * 12; float rs;
                if (ISQ) { const f32x4 s0 = *(const f32x4*)sp, s1 = *(const f32x4*)(sp + 4); rs = __builtin_amdgcn_rsqf(((s0[0] + s0[1]) + (s0[2] + s0[3]) + (s1[0] + s1[1]) + (s1[2] + s1[3])) * (1.0f / 512.0f) + EPS); }
                else { const f32x4 s0 = *(const f32x4*)(sp + 8); rs = __builtin_amdgcn_rsqf(((s0[0] + s0[1]) + (s0[2] + s0[3])) * (1.0f / 256.0f) + EPS); }
                const float* rp = rope + (size_t)(row & 2047) * 64 + ridx;
#pragma unroll
                for (int bj = 0; bj < 2; ++bj) { f32x4 a = acc[ai][bj][m][0] * rs, b = acc[ai][bj][m][1] * rs;
                    if (dorope) rope8(a, b, rp, fq < 2);
                    st8(O + (size_t)row * ld + pn * 256 + bj * HALF + cw, a, b); }
                asm volatile("" ::: "memory"); }
    }
};

struct EpiMerge {
    static constexpr bool PERM = true, AFTER_DRAIN = false, MIDHOOK = true;
    bf16_t* MG; const bf16_t* G;
    __device__ __forceinline__ void mid(f32x4 (&acc)[2][2][4][2], const Unit& u, int wr, int wc, int fr, int fq) const {
        const int col0 = u.pn * 256 + wc * 32 + 8 * fq; int rowb = u.pm * BM + wr * 64 + fr; asm volatile("" : "+v"(rowb));
#pragma unroll
        for (int ai = 0; ai < 2; ++ai)
#pragma unroll
            for (int m = 0; m < 4; ++m) { const bf16_t* gp = G + (size_t)(rowb + ai * HALF + m * 16) * 4096 + col0;
#pragma unroll
                for (int bj = 0; bj < 2; ++bj) { const u32x4 gd = *(const u32x4*)(gp + bj * HALF), gm = *(const u32x4*)(gp + 2048 + bj * HALF);
                    f32x4 r0, r1;
                    r0[0] = blo(gd.x) * __builtin_amdgcn_rcpf(blo(gm.x)); r0[1] = bhi(gd.x) * __builtin_amdgcn_rcpf(bhi(gm.x)); r0[2] = blo(gd.y) * __builtin_amdgcn_rcpf(blo(gm.y)); r0[3] = bhi(gd.y) * __builtin_amdgcn_rcpf(bhi(gm.y));
                    r1[0] = blo(gd.z) * __builtin_amdgcn_rcpf(blo(gm.z)); r1[1] = bhi(gd.z) * __builtin_amdgcn_rcpf(bhi(gm.z)); r1[2] = blo(gd.w) * __builtin_amdgcn_rcpf(blo(gm.w)); r1[3] = bhi(gd.w) * __builtin_amdgcn_rcpf(bhi(gm.w));
                    acc[ai][bj][m][0] *= r0; acc[ai][bj][m][1] *= r1; }
                asm volatile("" : "+v"(acc[ai][0][m][0]), "+v"(acc[ai][0][m][1]), "+v"(acc[ai][1][m][0]), "+v"(acc[ai][1][m][1]));
                asm volatile("" ::: "memory"); }
    }
    __device__ __forceinline__ void operator()(const f32x4 (&acc)[2][2][4][2], const Unit& u, int wr, int wc, int fr, int fq) const {
        const int col0 = u.pn * 256 + wc * 32 + 8 * fq; int rowb = u.pm * BM + wr * 64 + fr; asm volatile("" : "+v"(rowb));
#pragma unroll
        for (int ai = 0; ai < 2; ++ai)
#pragma unroll
            for (int m = 0; m < 4; ++m) { const int row = rowb + ai * HALF + m * 16; const bf16_t* gp = G + (size_t)row * 4096 + 2048 + col0;
#pragma unroll
                for (int bj = 0; bj < 2; ++bj) { const u32x4 gm = *(const u32x4*)(gp + bj * HALF);
                    const f32x4 g0 = (f32x4){blo(gm.x), bhi(gm.x), blo(gm.y), bhi(gm.y)}, g1 = (f32x4){blo(gm.z), bhi(gm.z), blo(gm.w), bhi(gm.w)};
                    st8(MG + (size_t)row * 2048 + col0 + bj * HALF, acc[ai][bj][m][0] * g0, acc[ai][bj][m][1] * g1); }
                asm volatile("" ::: "memory"); }
    }
};

struct EpiResid {
    static constexpr bool PERM = false, AFTER_DRAIN = false, MIDHOOK = false;
    float* xo; const float* xs; float* co; const float* cs; const float* gate; float* part;
    __device__ __forceinline__ void operator()(const f32x4 (&acc)[2][2][4][2], const Unit& u, int wr, int wc, int fr, int fq) const {
        const bool lat = u.pm < 128; const int col0 = u.pn * BM + wc * 32 + 4 * fq; int rowt = (lat ? u.pm : u.pm - 128) * BM + wr * 64 + fr; asm volatile("" : "+v"(rowt));
        float* ob = lat ? xo : co; const float* sb = lat ? xs : cs; const float* gp = gate + (size_t)(lat ? (u.pm >> 3) : 16) * 12288 + col0;
        f32x4 gv[2][2];
#pragma unroll
        for (int bj = 0; bj < 2; ++bj)
#pragma unroll
            for (int n = 0; n < 2; ++n) gv[bj][n] = *(const f32x4*)(gp + bj * HALF + n * 16);
#pragma unroll
        for (int ai = 0; ai < 2; ++ai)
#pragma unroll
            for (int m = 0; m < 4; ++m) { const size_t off = (size_t)(rowt + ai * HALF + m * 16) * 2048 + col0;
#pragma unroll
                for (int bj = 0; bj < 2; ++bj)
#pragma unroll
                    for (int n = 0; n < 2; ++n) {
                        if (u.cnt != 0) {
                            *(f32x4*)(part + (size_t)(u.kt0 != 0 ? 1 : 0) * ((size_t)MCTX * DM) + off + bj * HALF + n * 16) = gv[bj][n] * acc[ai][bj][m][n];
                        } else { const f32x4 s = *(const f32x4*)(sb + off + bj * HALF + n * 16); *(f32x4*)(ob + off + bj * HALF + n * 16) = s + gv[bj][n] * acc[ai][bj][m][n]; } }
                asm volatile("" ::: "memory"); }
    }
};

struct EpiRelu2 {
    static constexpr bool PERM = true, AFTER_DRAIN = false, MIDHOOK = false;
    bf16_t* U;
    __device__ __forceinline__ void operator()(const f32x4 (&acc)[2][2][4][2], const Unit& u, int wr, int wc, int fr, int fq) const {
        const int col0 = u.pn * 256 + wc * 32 + 8 * fq; int rowb = u.pm * BM + wr * 64 + fr; asm volatile("" : "+v"(rowb));
#pragma unroll
        for (int ai = 0; ai < 2; ++ai)
#pragma unroll
            for (int m = 0; m < 4; ++m) { bf16_t* rowp = U + (size_t)(rowb + ai * HALF + m * 16) * 8192 + col0;
#pragma unroll
                for (int bj = 0; bj < 2; ++bj) { f32x4 a = acc[ai][bj][m][0], b = acc[ai][bj][m][1];
#pragma unroll
                    for (int e = 0; e < 4; ++e) { const float x = fmaxf(a[e], 0.f), y = fmaxf(b[e], 0.f); a[e] = x * x; b[e] = y * y; }
                    st8(rowp + bj * HALF, a, b); } }
    }
};
template <class Epi, class Sched, bool ALIGN_EPI = false, bool SP2 = false>
__device__ __forceinline__ void gemm_phase(PG8_LAS unsigned char* lds, const Gemm g, const Sched& S, const Epi& E) {
    int tid_ = threadIdx.x; asm volatile("" : "+v"(tid_));
    const int tid = tid_, wid = __builtin_amdgcn_readfirstlane(tid >> 6), lane = tid & 63, wr = wid >> 2, wc = wid & 3, fr = lane & 15, fq = lane >> 4;
    int K_ = g.K; asm volatile("" : "+s"(K_));
    const int K = K_, nt = K / BK;
    unsigned voffA[2], voffB[2];
#pragma unroll
    for (int i = 0; i < 2; ++i) { int R, C; stage_rc(tid * 16 + i * 8192, R, C); const int Rb = Epi::PERM ? ((R & ~31) + perm32(R & 31)) : R;
        voffA[i] = (unsigned)(R * K + C) * 2u; voffB[i] = (unsigned)(Rb * K + C) * 2u; }
    const size_t kstep = (size_t)(BK * 2);
    const size_t hstep = (size_t)HALF * K * 2;
    const size_t tstep = 2 * hstep;
    const unsigned ldsw = (unsigned)wid * 1024u;
    const int aoff = lds_byte(wr * 64 + fr, fq * 8), boff = lds_byte(wc * 32 + fr, fq * 8);
#define PG8_SA(b, h) (((b) * 2 + (h)) * HTB)
#define PG8_SB(b, h) ((4 + (b) * 2 + (h)) * HTB)
#define PG8_STAGE(bufoff, gbase, voff) do { _Pragma("unroll") for (int _i = 0; _i < 2; ++_i) \
        __builtin_amdgcn_global_load_lds((const unsigned*)((const char*)(gbase) + (voff)[_i]), (PG8_LAS unsigned*)(lds + (bufoff) + ldsw + _i * 8192), 16, 0, 0); } while (0)
#define PG8_LDA(dst, b, h) do { _Pragma("unroll") for (int m = 0; m < 4; ++m) _Pragma("unroll") for (int k = 0; k < 2; ++k) dst[m][k] = *(const PG8_LAS bf16x8*)(lds + PG8_SA(b, h) + aoff + m * 2048 + k * 1024); } while (0)
#define PG8_LDB(dst, b, h) do { _Pragma("unroll") for (int n = 0; n < 2; ++n) _Pragma("unroll") for (int k = 0; k < 2; ++k) dst[n][k] = *(const PG8_LAS bf16x8*)(lds + PG8_SB(b, h) + boff + n * 2048 + k * 1024); } while (0)
#define PG8_MMA(ai, bj, At, Bt) do { __builtin_amdgcn_s_setprio(1); _Pragma("unroll") for (int m = 0; m < 4; ++m) _Pragma("unroll") for (int n = 0; n < 2; ++n) _Pragma("unroll") for (int k = 0; k < 2; ++k) \
        acc[ai][bj][m][n] = __builtin_amdgcn_mfma_f32_16x16x32_bf16(Bt[n][k], At[m][k], acc[ai][bj][m][n], 0, 0, 0); __builtin_amdgcn_s_setprio(0); } while (0)
#define PG8_WAIT_V(n) asm volatile("s_waitcnt vmcnt(" #n ")" ::: "memory")
#define PG8_WAIT_L(n) asm volatile("s_waitcnt lgkmcnt(" #n ")" ::: "memory")
#define PG8_BAR __builtin_amdgcn_s_barrier()
#define PG8_SCHED __builtin_amdgcn_sched_barrier(0)
    Unit cur, nxt; int ui = 0;
    if (!S.next(0, cur)) return;
    f32x4 acc[2][2][4][2];
#pragma unroll
    for (int a = 0; a < 2; ++a)
#pragma unroll
        for (int b = 0; b < 2; ++b)
#pragma unroll
            for (int m = 0; m < 4; ++m)
#pragma unroll
                for (int n = 0; n < 2; ++n) acc[a][b][m][n] = (f32x4){0.f, 0.f, 0.f, 0.f};
    bf16x8 At[4][2], B0[2][2], B1[2][2];
    const char* cA = (const char*)g.A + (size_t)cur.pm * tstep + (size_t)cur.kt0 * kstep; const char* cB = (const char*)g.Bt + (size_t)cur.pn * tstep + (size_t)cur.kt0 * kstep;
    S.a_ready(cur);
    if constexpr (SP2) {
        PG8_STAGE(PG8_SB(0, 0), cB, voffB); PG8_STAGE(PG8_SB(0, 1), cB + hstep, voffB); PG8_STAGE(PG8_SA(0, 0), cA, voffA); PG8_STAGE(PG8_SA(0, 1), cA + hstep, voffA);
        if (wr == 1) PG8_BAR;
        PG8_WAIT_V(2); PG8_BAR;
        PG8_STAGE(PG8_SB(1, 0), cB + kstep, voffB); PG8_STAGE(PG8_SA(1, 0), cA + kstep, voffA); PG8_STAGE(PG8_SB(1, 1), cB + hstep + kstep, voffB);
        PG8_WAIT_V(6); PG8_BAR;
    } else {
        PG8_STAGE(PG8_SB(0, 0), cB, voffB); PG8_STAGE(PG8_SA(0, 0), cA, voffA); PG8_STAGE(PG8_SB(0, 1), cB + hstep, voffB); PG8_STAGE(PG8_SA(0, 1), cA + hstep, voffA);
        if (wr == 1) PG8_BAR;
        PG8_WAIT_V(4); PG8_BAR;
        PG8_STAGE(PG8_SB(1, 0), cB + kstep, voffB); PG8_STAGE(PG8_SA(1, 0), cA + kstep, voffA); PG8_STAGE(PG8_SB(1, 1), cB + hstep + kstep, voffB);
        PG8_WAIT_V(6); PG8_BAR;
    }
    for (;;) {
        const bool has_next = S.next(ui + 1, nxt);
        const char* nA = has_next ? (const char*)g.A + (size_t)nxt.pm * tstep + (size_t)nxt.kt0 * kstep : cA; const char* nB = has_next ? (const char*)g.Bt + (size_t)nxt.pn * tstep + (size_t)nxt.kt0 * kstep : cB;
        const int cnt = cur.cnt ? cur.cnt : nt;
        for (int t = 0; t < cnt; t += 2) {
            const bool last = (t == cnt - 2);
            if constexpr (Epi::MIDHOOK) { if (t == (cnt >> 1)) E.mid(acc, cur, wr, wc, fr, fq); }
            const char* a1 = cA + (size_t)(t + 1) * kstep;
            const char* a2 = last ? nA : cA + (size_t)(t + 2) * kstep; const char* b2 = last ? nB : cB + (size_t)(t + 2) * kstep;
            const char* a3 = a2 + kstep; const char* b3 = b2 + kstep;
            if (last && has_next) S.a_ready(nxt);
            if constexpr (SP2) {
            PG8_LDB(B0, 0, 0); PG8_LDB(B1, 0, 1); PG8_SCHED; PG8_LDA(At, 0, 0); PG8_STAGE(PG8_SA(1, 1), a1 + hstep, voffA);
            PG8_WAIT_V(8); PG8_WAIT_L(0); PG8_BAR; PG8_MMA(0, 0, At, B0); PG8_MMA(0, 1, At, B1); PG8_BAR; PG8_SCHED;
            PG8_LDA(At, 0, 1); PG8_STAGE(PG8_SB(0, 0), b2, voffB); PG8_STAGE(PG8_SB(0, 1), b2 + hstep, voffB); PG8_STAGE(PG8_SA(0, 0), a2, voffA);
            PG8_WAIT_V(8); PG8_WAIT_L(0); PG8_BAR; PG8_MMA(1, 0, At, B0); PG8_MMA(1, 1, At, B1); PG8_BAR; PG8_SCHED;
            PG8_LDB(B0, 1, 0); PG8_LDB(B1, 1, 1); PG8_SCHED; PG8_LDA(At, 1, 0); PG8_STAGE(PG8_SA(0, 1), a2 + hstep, voffA);
            PG8_WAIT_V(8); PG8_WAIT_L(0); PG8_BAR; PG8_MMA(0, 0, At, B0); PG8_MMA(0, 1, At, B1); PG8_BAR; PG8_SCHED;
            PG8_LDA(At, 1, 1); PG8_STAGE(PG8_SB(1, 0), b3, voffB); PG8_STAGE(PG8_SB(1, 1), b3 + hstep, voffB); PG8_STAGE(PG8_SA(1, 0), a3, voffA);
            PG8_WAIT_V(8); PG8_WAIT_L(0); PG8_BAR; PG8_MMA(1, 0, At, B0); PG8_MMA(1, 1, At, B1); PG8_BAR; PG8_SCHED;
            } else {
            PG8_LDB(B0, 0, 0); PG8_SCHED; PG8_LDA(At, 0, 0); PG8_STAGE(PG8_SA(1, 1), a1 + hstep, voffA);
            PG8_WAIT_L(8); PG8_BAR; PG8_WAIT_L(0); PG8_MMA(0, 0, At, B0); PG8_BAR; PG8_SCHED;
            PG8_LDB(B1, 0, 1); PG8_STAGE(PG8_SB(0, 0), b2, voffB);
            PG8_BAR; PG8_WAIT_L(0); PG8_MMA(0, 1, At, B1); PG8_BAR;
            PG8_LDA(At, 0, 1); PG8_STAGE(PG8_SA(0, 0), a2, voffA);
            PG8_BAR; PG8_WAIT_L(0); PG8_MMA(1, 0, At, B0); PG8_BAR; PG8_SCHED;
            PG8_STAGE(PG8_SB(0, 1), b2 + hstep, voffB);
            PG8_WAIT_V(6); PG8_BAR; PG8_MMA(1, 1, At, B1); PG8_BAR;
            PG8_LDB(B0, 1, 0); PG8_SCHED; PG8_LDA(At, 1, 0); PG8_STAGE(PG8_SA(0, 1), a2 + hstep, voffA);
            PG8_WAIT_L(8); PG8_BAR; PG8_WAIT_L(0); PG8_MMA(0, 0, At, B0); PG8_BAR; PG8_SCHED;
            PG8_LDB(B1, 1, 1); PG8_STAGE(PG8_SB(1, 0), b3, voffB);
            PG8_BAR; PG8_WAIT_L(0); PG8_MMA(0, 1, At, B1); PG8_BAR;
            PG8_LDA(At, 1, 1); PG8_STAGE(PG8_SA(1, 0), a3, voffA);
            PG8_BAR; PG8_WAIT_L(0); PG8_MMA(1, 0, At, B0); PG8_BAR; PG8_SCHED;
            PG8_STAGE(PG8_SB(1, 1), b3 + hstep, voffB);
            PG8_WAIT_V(6); PG8_BAR; PG8_MMA(1, 1, At, B1); PG8_BAR;
            }
        }
        if constexpr (ALIGN_EPI) { if (wr == 0) PG8_BAR; }
        if constexpr (!Epi::AFTER_DRAIN) { E(acc, cur, wr, wc, fr, fq); S.done(cur); }
        if (!has_next) break;
#pragma unroll
        for (int a = 0; a < 2; ++a)
#pragma unroll
            for (int b = 0; b < 2; ++b)
#pragma unroll
                for (int m = 0; m < 4; ++m)
#pragma unroll
                    for (int n = 0; n < 2; ++n) acc[a][b][m][n] = (f32x4){0.f, 0.f, 0.f, 0.f};
        cur = nxt; cA = nA; cB = nB; ++ui;
        if constexpr (ALIGN_EPI) { if (wr == 1) PG8_BAR; }
    }
    PG8_WAIT_V(0);
    if constexpr (!ALIGN_EPI) { if (wr == 0) PG8_BAR; }
    PG8_BAR;
    if constexpr (Epi::AFTER_DRAIN) { E.fused(acc, cur, wr, wc, fr, fq, lds, wid, lane); S.done(cur); }
#undef PG8_SA
#undef PG8_SB
#undef PG8_STAGE
#undef PG8_LDA
#undef PG8_LDB
#undef PG8_MMA
#undef PG8_WAIT_V
#undef PG8_WAIT_L
#undef PG8_BAR
#undef PG8_SCHED
}
}
#define XB_TMO      128
#define XB_XCNT(j)  (256  + 64 * (j))
#define XB_XSUB(j)  (1280 + 64 * (j))
#define XB_XGEN(j)  (2304 + 64 * (j))
#define XB_TOP      3328
#define XB_TOPGEN   3392
#define XCD_BAR_WORDS 3456
#define XB_SPIN_CAP (1u << 18)

__device__ __forceinline__ unsigned xb_ld(unsigned* p)              { return __hip_atomic_load(p, __ATOMIC_RELAXED, __HIP_MEMORY_SCOPE_AGENT); }
__device__ __forceinline__ unsigned xb_add(unsigned* p, unsigned v) { return __hip_atomic_fetch_add(p, v, __ATOMIC_RELAXED, __HIP_MEMORY_SCOPE_AGENT); }
__device__ __forceinline__ unsigned xb_xcc_id() { return (unsigned)__builtin_amdgcn_s_getreg((3 << 11) | 20) & 0xFu; }
#define XB_SPIN(cond, bar) do { unsigned _sp = 0; while (cond) { __builtin_amdgcn_s_sleep(1); \
    if ((++_sp & 255u) == 0u) { if (xb_ld(&(bar)[XB_TMO])) break; if (_sp > XB_SPIN_CAP) { atomicAdd(&(bar)[XB_TMO], 1u); break; } } } } while (0)

struct XcdBarrier {
    unsigned* bar; unsigned x;
    volatile LAS unsigned* st;
};

__device__ __forceinline__ XcdBarrier xcd_barrier_post(unsigned* bar, volatile LAS unsigned* st) {
    XcdBarrier b; b.bar = bar; b.x = xb_xcc_id(); b.st = st;
    if (threadIdx.x == 0) (void)xb_add(&bar[XB_XCNT(b.x)], 1u);
    return b;
}
__device__ __forceinline__ void xcd_barrier_complete(unsigned* bar, unsigned x, unsigned& nloc, unsigned& nx) {
    const unsigned G = gridDim.x * gridDim.y * gridDim.z;
    unsigned sum, cnt, mine, sp = 0u;
    for (;;) {
        sum = 0u; cnt = 0u; mine = 0u;
#pragma unroll
        for (unsigned j = 0; j < 16; ++j) { const unsigned c = xb_ld(&bar[XB_XCNT(j)]); sum += c; cnt += (c > 0u) ? 1u : 0u; mine = (j == x) ? c : mine; }
        if (sum == G) break;
        __builtin_amdgcn_s_sleep(1);
        if ((++sp & 255u) == 0u) { if (xb_ld(&bar[XB_TMO])) break; if (sp > XB_SPIN_CAP) { atomicAdd(&bar[XB_TMO], 1u); break; } }
    }
    nloc = mine > 0u ? mine : 1u; nx = cnt > 0u ? cnt : 1u;
}

__device__ __forceinline__ void xcd_barrier(const XcdBarrier& b) {
    asm volatile("s_waitcnt vmcnt(0)" ::: "memory");
    __syncthreads();
    if (threadIdx.x == 0) {
        unsigned* bar = b.bar;
        __builtin_amdgcn_s_waitcnt(0);
        unsigned nloc = b.st[0], nx = b.st[1];
        if (nloc == 0u) { xcd_barrier_complete(bar, b.x, nloc, nx); b.st[0] = nloc; b.st[1] = nx; }
        const unsigned old = xb_add(&bar[XB_XSUB(b.x)], 1u);
        const unsigned gen = old / nloc;
        if (old + 1u == (gen + 1u) * nloc) {
            __builtin_amdgcn_fence(__ATOMIC_RELEASE, "agent");
            asm volatile("s_waitcnt vmcnt(0)" ::: "memory");
            const unsigned og = xb_add(&bar[XB_TOP], 1u);
            const unsigned tg = og / nx;
            if (og + 1u == (tg + 1u) * nx) xb_add(&bar[XB_TOPGEN], 1u);
            else XB_SPIN(xb_ld(&bar[XB_TOPGEN]) == tg, bar);
            __builtin_amdgcn_fence(__ATOMIC_ACQUIRE, "agent");
            xb_add(&bar[XB_XGEN(b.x)], 1u);
            asm volatile("s_waitcnt vmcnt(0)" ::: "memory");
        } else {
            XB_SPIN(xb_ld(&bar[XB_XGEN(b.x)]) == gen, bar);
            __builtin_amdgcn_fence(__ATOMIC_ACQUIRE, "agent");
            asm volatile("s_waitcnt vmcnt(0)" ::: "memory");
        }
    }
    __syncthreads();
}
namespace att {
using bf16x8 = __attribute__((ext_vector_type(8))) short;
using s16x4  = __attribute__((ext_vector_type(4))) short;
using f32x16 = __attribute__((ext_vector_type(16))) float;
using u32x4  = __attribute__((ext_vector_type(4))) unsigned;
typedef LAS char* lptr;
#define ATT_SBAR() __builtin_amdgcn_sched_barrier(0)
constexpr int NW = 8, KVBLK = 64;
constexpr int SHM_V = 16384, SHM_K = 16384, SHM_KP = 8192;
constexpr int L_V = 0, L_K = 2 * SHM_V, L_KP = L_K + 2 * SHM_K, L_WS = L_KP + 2 * SHM_KP, L_END = L_WS + NW * 64 * 4;
__device__ __forceinline__ int kswz(int row, int colB) { return row * 256 + (colB ^ ((row & 15) << 4)); }
__device__ __forceinline__ int kswz64(int row, int colB) { return row * 128 + (colB ^ ((((row >> 1) & 3) | (((row >> 4) & 1) << 2)) << 4)); }
__device__ __forceinline__ int crow(int r, int hi) { return (r & 3) + 8 * (r >> 2) + 4 * hi; }
typedef float cvt_f32x2_t __attribute__((ext_vector_type(2))); typedef __bf16 cvt_bf16x2_t __attribute__((ext_vector_type(2)));
__device__ __forceinline__ unsigned cvtpk(float lo, float hi) { cvt_f32x2_t v = {lo, hi}; cvt_bf16x2_t b = __builtin_convertvector(v, cvt_bf16x2_t); return __builtin_bit_cast(unsigned, b); }
__device__ __forceinline__ int v_st(int k, int c) { const int kk = (k & ~0xC) | ((k & 4) << 1) | ((k & 8) >> 1); return ((kk >> 3) * 4 + (c >> 5)) * 512 + ((kk & 7) * 32 + (c & 31)) * 2; }
__device__ __forceinline__ int v_rd_base(int lane) { return ((lane & 3) << 3) | (((lane >> 2) & 3) << 6) | (((lane >> 4) & 1) << 5) | (((lane >> 5) & 1) << 8); }
constexpr int v_rd_off(int d0, int ks, int half) { return d0 * 512 + ks * 4096 + half * 2048; }
template <int OFF> __device__ __forceinline__ s16x4 tr_read(int vb) { s16x4 r; asm volatile("ds_read_b64_tr_b16 %0, %1 offset:%2" : "=&v"(r) : "v"(vb), "i"(OFF) : "memory"); return r; }
template <int D0> __device__ __forceinline__ void pv_one(f32x16& od, int vb, bf16x8 pa0, bf16x8 pa1, bf16x8 pa2, bf16x8 pa3) {
    const s16x4 l0 = tr_read<v_rd_off(D0, 0, 0)>(vb), h0 = tr_read<v_rd_off(D0, 0, 1)>(vb), l1 = tr_read<v_rd_off(D0, 1, 0)>(vb), h1 = tr_read<v_rd_off(D0, 1, 1)>(vb);
    const s16x4 l2 = tr_read<v_rd_off(D0, 2, 0)>(vb), h2 = tr_read<v_rd_off(D0, 2, 1)>(vb), l3 = tr_read<v_rd_off(D0, 3, 0)>(vb), h3 = tr_read<v_rd_off(D0, 3, 1)>(vb);
    asm volatile("s_waitcnt lgkmcnt(0)" ::: "memory"); ATT_SBAR();
#define ATT_PK(L, H) (bf16x8){L[0], L[1], L[2], L[3], H[0], H[1], H[2], H[3]}
    od = __builtin_amdgcn_mfma_f32_32x32x16_bf16(pa0, ATT_PK(l0, h0), od, 0, 0, 0);
    od = __builtin_amdgcn_mfma_f32_32x32x16_bf16(pa1, ATT_PK(l1, h1), od, 0, 0, 0);
    od = __builtin_amdgcn_mfma_f32_32x32x16_bf16(pa2, ATT_PK(l2, h2), od, 0, 0, 0);
    od = __builtin_amdgcn_mfma_f32_32x32x16_bf16(pa3, ATT_PK(l3, h3), od, 0, 0, 0);
#undef ATT_PK
}
__device__ __forceinline__ void pv_d0(f32x16* o, int vb, bf16x8 pa0, bf16x8 pa1, bf16x8 pa2, bf16x8 pa3) {
    pv_one<0>(o[0], vb, pa0, pa1, pa2, pa3); pv_one<1>(o[1], vb, pa0, pa1, pa2, pa3); pv_one<2>(o[2], vb, pa0, pa1, pa2, pa3); pv_one<3>(o[3], vb, pa0, pa1, pa2, pa3);
}
__device__ __forceinline__ bf16x8 ldg8(const bf16* p) { return *reinterpret_cast<const bf16x8*>(p); }

struct Args {
    const bf16 *QD, *KD, *VD, *QM, *KVM, *KR; bf16* Y; const float* subln; float lam, omli;
};

template <int MODE>
__device__ __forceinline__ void attn_unit(const Args& A, int b, int h, int qb, bool isctx, lptr lds) {
    int tid_ = threadIdx.x; asm volatile("" : "+v"(tid_));
    const int tid = tid_, lane = tid & 63, r32 = lane & 31, hi = lane >> 5; const int wid = __builtin_amdgcn_readfirstlane(tid >> 6);
    const int comp = (MODE == 0) ? (wid >> 2) : 0, wq = (MODE == 0) ? (wid & 3) : wid;
    constexpr int QROWS = (MODE == 0) ? 128 : 256;
    const int ctx0 = MLAT + b * CTXL, lat0 = b * SEQ;
    const int qrow0 = (isctx ? ctx0 : lat0) + qb * QROWS + wq * 32;
    const int NT = isctx ? 4 : 36;
    constexpr float C = (MODE == 0) ? LOG2E : MLA_SCALE * LOG2E;
    constexpr int NQ = (MODE == 0) ? 4 : 12;
    bf16x8 qr[NQ];
    if constexpr (MODE == 0) { const bf16* qp = A.QD + (size_t)(qrow0 + r32) * 1024 + h * 128 + comp * 64 + hi * 8;
#pragma unroll
        for (int d0 = 0; d0 < 4; ++d0) qr[d0] = ldg8(qp + d0 * 16);
    } else { const bf16* qp = A.QM + (size_t)(qrow0 + r32) * 1536 + h * 128 + hi * 8; const bf16* qe = A.QM + (size_t)(qrow0 + r32) * 1536 + 1024 + h * 64 + hi * 8;
#pragma unroll
        for (int d0 = 0; d0 < 8; ++d0) qr[d0] = ldg8(qp + d0 * 16);
#pragma unroll
        for (int d0 = 0; d0 < 4; ++d0) qr[8 + d0] = ldg8(qe + d0 * 16);
    }
    const int sr = tid >> 4, sc = (tid & 15) * 8, vst0 = v_st(sr, sc), vst1 = v_st(32 + sr, sc), kst0 = kswz(sr, sc * 2), kst1 = kswz(32 + sr, sc * 2);
    const int pr = tid >> 3, pc = (tid & 7) * 8, pst = kswz64(pr, pc * 2);
    const bf16* Kg = (MODE == 0) ? A.KD + h * 128 : A.KVM + h * 128; const bf16* Vg = (MODE == 0) ? A.VD + h * 128 : A.KVM + 1024 + h * 128;
    constexpr int LDK = (MODE == 0) ? 1024 : 2048;
    bf16x8 vs0, vs1, ks0, ks1, kp0;
#define ATT_KROW(j) ((j) < 4 ? ctx0 + 64 * (j) : lat0 + 64 * ((j) - 4))
#define ATT_SLOAD(j) do { const int k0_ = ATT_KROW(j); \
        vs0 = ldg8(Vg + (size_t)(k0_ + sr) * LDK + sc); vs1 = ldg8(Vg + (size_t)(k0_ + 32 + sr) * LDK + sc); \
        ks0 = ldg8(Kg + (size_t)(k0_ + sr) * LDK + sc); ks1 = ldg8(Kg + (size_t)(k0_ + 32 + sr) * LDK + sc); \
        if constexpr (MODE == 1) kp0 = ldg8(A.KR + (size_t)(k0_ + pr) * 64 + pc); } while (0)
#define ATT_SWRITE(bb) do { *(LAS bf16x8*)(lds + L_V + (bb) * SHM_V + vst0) = vs0; *(LAS bf16x8*)(lds + L_V + (bb) * SHM_V + vst1) = vs1; \
        *(LAS bf16x8*)(lds + L_K + (bb) * SHM_K + kst0) = ks0; *(LAS bf16x8*)(lds + L_K + (bb) * SHM_K + kst1) = ks1; \
        if constexpr (MODE == 1) *(LAS bf16x8*)(lds + L_KP + (bb) * SHM_KP + pst) = kp0; } while (0)
    LAS float* wsf = (LAS float*)(lds + L_WS) + wid * 64;
    const int vb0 = (int)(uintptr_t)(lds + L_V) + v_rd_base(lane);
    float m_reg = -1e30f, l_reg = 0.f; f32x16 o[4];
#pragma unroll
    for (int d = 0; d < 4; ++d) o[d] = f32x16{};
    ATT_SLOAD(0); ATT_SWRITE(0); __syncthreads();
    for (int j = 0; j < NT; ++j) {
        const int cur = j & 1;
        if (j + 1 < NT) ATT_SLOAD(j + 1);
        f32x16 p0 = f32x16{}, p1 = f32x16{};
        { const lptr Kb = lds + L_K + cur * SHM_K;
          if constexpr (MODE == 0) {
#pragma unroll
            for (int d0 = 0; d0 < 4; ++d0) { const int cb = (comp * 64 + d0 * 16 + hi * 8) * 2;
                const bf16x8 b0 = *(const LAS bf16x8*)(Kb + kswz(r32, cb)), b1 = *(const LAS bf16x8*)(Kb + kswz(32 + r32, cb));
                p0 = __builtin_amdgcn_mfma_f32_32x32x16_bf16(b0, qr[d0], p0, 0, 0, 0); p1 = __builtin_amdgcn_mfma_f32_32x32x16_bf16(b1, qr[d0], p1, 0, 0, 0); }
          } else {
#pragma unroll
            for (int d0 = 0; d0 < 8; ++d0) { const int cb = (d0 * 16 + hi * 8) * 2;
                const bf16x8 b0 = *(const LAS bf16x8*)(Kb + kswz(r32, cb)), b1 = *(const LAS bf16x8*)(Kb + kswz(32 + r32, cb));
                p0 = __builtin_amdgcn_mfma_f32_32x32x16_bf16(b0, qr[d0], p0, 0, 0, 0); p1 = __builtin_amdgcn_mfma_f32_32x32x16_bf16(b1, qr[d0], p1, 0, 0, 0); }
            const lptr Pb = lds + L_KP + cur * SHM_KP;
#pragma unroll
            for (int d0 = 0; d0 < 4; ++d0) { const int cb = (d0 * 16 + hi * 8) * 2;
                const bf16x8 b0 = *(const LAS bf16x8*)(Pb + kswz64(r32, cb)), b1 = *(const LAS bf16x8*)(Pb + kswz64(32 + r32, cb));
                p0 = __builtin_amdgcn_mfma_f32_32x32x16_bf16(b0, qr[8 + d0], p0, 0, 0, 0); p1 = __builtin_amdgcn_mfma_f32_32x32x16_bf16(b1, qr[8 + d0], p1, 0, 0, 0); }
          } }
        float pmax = p0[0];
#pragma unroll
        for (int r = 1; r < 16; ++r) pmax = fmaxf(pmax, p0[r]);
#pragma unroll
        for (int r = 0; r < 16; ++r) pmax = fmaxf(pmax, p1[r]);
        { auto rr = __builtin_amdgcn_permlane32_swap(__float_as_uint(pmax), __float_as_uint(pmax), false, false); pmax = fmaxf(__uint_as_float(rr[0]), __uint_as_float(rr[1])); }
        const float mn = fmaxf(m_reg, pmax), alpha = __builtin_amdgcn_exp2f((m_reg - mn) * C); m_reg = mn;
        const float mnC = -mn * C;
#pragma unroll
        for (int r = 0; r < 16; ++r) { p0[r] = __builtin_amdgcn_exp2f(fmaf(p0[r], C, mnC)); p1[r] = __builtin_amdgcn_exp2f(fmaf(p1[r], C, mnC)); }
        float ps = 0.f;
#pragma unroll
        for (int r = 0; r < 16; ++r) ps += p0[r] + p1[r];
        { auto rr = __builtin_amdgcn_permlane32_swap(__float_as_uint(ps), __float_as_uint(ps), false, false); ps = __uint_as_float(rr[0]) + __uint_as_float(rr[1]); }
        l_reg = l_reg * alpha + ps;
        bf16x8 pa0, pa1, pa2, pa3;
#define ATT_PK4(P, BASE, OUT) do { unsigned a0 = cvtpk(P[BASE + 0], P[BASE + 1]), a1 = cvtpk(P[BASE + 2], P[BASE + 3]); \
        unsigned b0 = cvtpk(P[BASE + 4], P[BASE + 5]), b1 = cvtpk(P[BASE + 6], P[BASE + 7]); \
        auto r0 = __builtin_amdgcn_permlane32_swap(a0, b0, false, false); auto r1 = __builtin_amdgcn_permlane32_swap(a1, b1, false, false); \
        u32x4 w = {r0[0], r1[0], r0[1], r1[1]}; OUT = __builtin_bit_cast(bf16x8, w); } while (0)
        ATT_PK4(p0, 0, pa0); ATT_PK4(p0, 8, pa1); ATT_PK4(p1, 0, pa2); ATT_PK4(p1, 8, pa3);
#undef ATT_PK4
        if (__any(alpha < 1.f)) { if (hi == 0) wsf[r32] = alpha; asm volatile("s_waitcnt lgkmcnt(0)" ::: "memory");
#pragma unroll
            for (int r = 0; r < 16; ++r) { const float al = wsf[crow(r, hi)];
#pragma unroll
                for (int d = 0; d < 4; ++d) o[d][r] *= al; }
            asm volatile("s_waitcnt lgkmcnt(0)" ::: "memory"); }
        ATT_SBAR();
        pv_d0(o, vb0 + cur * SHM_V, pa0, pa1, pa2, pa3);
        if (j + 1 < NT) ATT_SWRITE(cur ^ 1);
        __syncthreads();
    }
    if (hi == 0) wsf[32 + r32] = l_reg; asm volatile("s_waitcnt lgkmcnt(0)" ::: "memory");
    float rli[16];
#pragma unroll
    for (int r = 0; r < 16; ++r) rli[r] = 1.0f / wsf[32 + crow(r, hi)];
    asm volatile("s_waitcnt lgkmcnt(0)" ::: "memory");
    if constexpr (MODE == 1) {
        bf16* Yp = A.Y + (size_t)qrow0 * 2048 + 1024 + h * 128 + r32;
#pragma unroll
        for (int r = 0; r < 16; ++r) { const int orow = crow(r, hi);
#pragma unroll
            for (int d = 0; d < 4; ++d) Yp[(size_t)orow * 2048 + d * 32] = (bf16)f2bf(o[d][r] * rli[r]); }
        __syncthreads();
    } else {
        LAS float* xch = (LAS float*)lds;
        if (comp == 1) {
#pragma unroll
            for (int d = 0; d < 4; ++d)
#pragma unroll
                for (int r = 0; r < 16; ++r) xch[(wq * 64 + d * 16 + r) * 64 + lane] = A.lam * (o[d][r] * rli[r]);
        }
        __syncthreads();
        if (comp == 0) {
            bf16* Yp = A.Y + (size_t)qrow0 * 2048 + h * 128 + r32;
            float g[4];
#pragma unroll
            for (int d = 0; d < 4; ++d) g[d] = A.subln[d * 32 + r32] * A.omli;
#pragma unroll
            for (int r = 0; r < 16; ++r) { float v[4]; float ss = 0.f;
#pragma unroll
                for (int d = 0; d < 4; ++d) { v[d] = o[d][r] * rli[r] - xch[(wq * 64 + d * 16 + r) * 64 + lane]; ss += v[d] * v[d]; }
                ss += __shfl_xor(ss, 1); ss += __shfl_xor(ss, 2); ss += __shfl_xor(ss, 4); ss += __shfl_xor(ss, 8); ss += __shfl_xor(ss, 16);
                const float rs = 1.0f / sqrtf(ss * (1.0f / 128.0f) + EPS); const int orow = crow(r, hi);
#pragma unroll
                for (int d = 0; d < 4; ++d) Yp[(size_t)orow * 2048 + d * 32] = (bf16)f2bf(v[d] * rs * g[d]); }
        }
        __syncthreads();
    }
#undef ATT_KROW
#undef ATT_SLOAD
#undef ATT_SWRITE
}

constexpr int L2_QP = L_WS + NW * 64 * 4;
constexpr int L2_END = L2_QP + 32768;
template <int MODE> __device__ __forceinline__ void partial_sm(f32x16& p0, f32x16& p1, float& m_reg, float& mn, float& alpha) {
    constexpr float SC = (MODE == 0) ? 1.0f : MLA_SCALE, C = SC * LOG2E, THRS = 8.0f / SC;
    float pmax = p0[0];
#pragma unroll
    for (int r = 1; r < 16; ++r) pmax = fmaxf(pmax, p0[r]);
#pragma unroll
    for (int r = 0; r < 16; ++r) pmax = fmaxf(pmax, p1[r]);
    { auto rr = __builtin_amdgcn_permlane32_swap(__float_as_uint(pmax), __float_as_uint(pmax), false, false); pmax = fmaxf(__uint_as_float(rr[0]), __uint_as_float(rr[1])); }
    if (__builtin_expect(__all(pmax - m_reg <= THRS), 1)) { mn = m_reg; alpha = 1.f; }
    else { mn = fmaxf(m_reg, pmax); alpha = __builtin_amdgcn_exp2f((m_reg - mn) * C); m_reg = mn; }
    const float mnC = -mn * C;
#pragma unroll
    for (int r = 0; r < 16; ++r) p0[r] = fmaf(p0[r], C, mnC);
#pragma unroll
    for (int r = 0; r < 16; ++r) p1[r] = fmaf(p1[r], C, mnC);
#pragma unroll
    for (int r = 0; r < 16; ++r) p0[r] = __builtin_amdgcn_exp2f(p0[r]);
}
__device__ __forceinline__ void finish_sm(f32x16& p0, f32x16& p1, float alpha, float& l_reg, bf16x8& pa0, bf16x8& pa1, bf16x8& pa2, bf16x8& pa3) {
#pragma unroll
    for (int r = 0; r < 16; ++r) p1[r] = __builtin_amdgcn_exp2f(p1[r]);
    float ps = 0.f;
#pragma unroll
    for (int r = 0; r < 16; ++r) ps += p0[r];
#pragma unroll
    for (int r = 0; r < 16; ++r) ps += p1[r];
    { auto rr = __builtin_amdgcn_permlane32_swap(__float_as_uint(ps), __float_as_uint(ps), false, false); ps = __uint_as_float(rr[0]) + __uint_as_float(rr[1]); }
    l_reg = l_reg * alpha + ps;
#define ATT_PK4(P, BASE, OUT) do { unsigned a0 = cvtpk(P[BASE + 0], P[BASE + 1]), a1 = cvtpk(P[BASE + 2], P[BASE + 3]); \
    unsigned b0 = cvtpk(P[BASE + 4], P[BASE + 5]), b1 = cvtpk(P[BASE + 6], P[BASE + 7]); \
    auto r0 = __builtin_amdgcn_permlane32_swap(a0, b0, false, false); auto r1 = __builtin_amdgcn_permlane32_swap(a1, b1, false, false); \
    u32x4 w = {r0[0], r1[0], r0[1], r1[1]}; OUT = __builtin_bit_cast(bf16x8, w); } while (0)
    ATT_PK4(p0, 0, pa0); ATT_PK4(p0, 8, pa1); ATT_PK4(p1, 0, pa2); ATT_PK4(p1, 8, pa3);
#undef ATT_PK4
}
template <int MODE> __device__ __forceinline__ void qkt2(f32x16& p0, f32x16& p1, lptr Kb, lptr Pb, const bf16x8* qr, lptr qpl, int comp, int r32, int hi) {
    p0 = f32x16{}; p1 = f32x16{};
    constexpr int ND = (MODE == 0) ? 4 : 8;
#pragma unroll
    for (int d0 = 0; d0 < ND; ++d0) { const int cb = (((MODE == 0) ? comp * 64 : 0) + d0 * 16 + hi * 8) * 2;
        const bf16x8 b0 = *(const LAS bf16x8*)(Kb + kswz(r32, cb)), b1 = *(const LAS bf16x8*)(Kb + kswz(32 + r32, cb));
        p0 = __builtin_amdgcn_mfma_f32_32x32x16_bf16(b0, qr[d0], p0, 0, 0, 0); p1 = __builtin_amdgcn_mfma_f32_32x32x16_bf16(b1, qr[d0], p1, 0, 0, 0); }
    if constexpr (MODE == 1) {
#pragma unroll
        for (int d0 = 0; d0 < 4; ++d0) { const int cb = (d0 * 16 + hi * 8) * 2; const bf16x8 q = *(const LAS bf16x8*)(qpl + d0 * 1024);
            const bf16x8 b0 = *(const LAS bf16x8*)(Pb + kswz64(r32, cb)), b1 = *(const LAS bf16x8*)(Pb + kswz64(32 + r32, cb));
            p0 = __builtin_amdgcn_mfma_f32_32x32x16_bf16(b0, q, p0, 0, 0, 0); p1 = __builtin_amdgcn_mfma_f32_32x32x16_bf16(b1, q, p1, 0, 0, 0); }
    }
}
template <int MODE>
__device__ __forceinline__ void attn_unit2(const Args& A, int b, int h, int qb, bool isctx, lptr lds) {
    int tid_ = threadIdx.x; asm volatile("" : "+v"(tid_));
    const int tid = tid_, lane = tid & 63, r32 = lane & 31, hi = lane >> 5; const int wid = __builtin_amdgcn_readfirstlane(tid >> 6);
    const int comp = (MODE == 0) ? (wid >> 2) : 0, wq = (MODE == 0) ? (wid & 3) : wid;
    constexpr int QROWS = (MODE == 0) ? 128 : 256, SD = (MODE == 0) ? 2 : 1;
    const int ctx0 = MLAT + b * CTXL, lat0 = b * SEQ;
    const int qrow0 = (isctx ? ctx0 : lat0) + qb * QROWS + wq * 32;
    const int NT = isctx ? 4 : 36;
    constexpr int NQ = (MODE == 0) ? 4 : 8;
    bf16x8 qr[NQ];
    const lptr qpl = lds + L2_QP + wid * 4096 + lane * 16;
    if constexpr (MODE == 0) { const bf16* qp = A.QD + (size_t)(qrow0 + r32) * 1024 + h * 128 + comp * 64 + hi * 8;
#pragma unroll
        for (int d0 = 0; d0 < 4; ++d0) qr[d0] = ldg8(qp + d0 * 16);
    } else { const bf16* qp = A.QM + (size_t)(qrow0 + r32) * 1536 + h * 128 + hi * 8; const bf16* qe = A.QM + (size_t)(qrow0 + r32) * 1536 + 1024 + h * 64 + hi * 8;
#pragma unroll
        for (int d0 = 0; d0 < 8; ++d0) qr[d0] = ldg8(qp + d0 * 16);
#pragma unroll
        for (int d0 = 0; d0 < 4; ++d0) *(LAS bf16x8*)(qpl + d0 * 1024) = ldg8(qe + d0 * 16);
    }
    const int sr = tid >> 4, sc = (tid & 15) * 8, vst0 = v_st(sr, sc), vst1 = v_st(32 + sr, sc), kst0 = kswz(sr, sc * 2), kst1 = kswz(32 + sr, sc * 2);
    const int pr = tid >> 3, pc = (tid & 7) * 8, pst = kswz64(pr, pc * 2);
    const bf16* Kg = (MODE == 0) ? A.KD + h * 128 : A.KVM + h * 128; const bf16* Vg = (MODE == 0) ? A.VD + h * 128 : A.KVM + 1024 + h * 128;
    constexpr int LDK = (MODE == 0) ? 1024 : 2048;
    struct { bf16x8 vs0, vs1, ks0, ks1, kp0; } st_[SD];
#define ATT_KROW(j) ((j) < 4 ? ctx0 + 64 * (j) : lat0 + 64 * ((j) - 4))
#define ATT_SLOAD(i, j) do { const int k0_ = ATT_KROW(j); \
        st_[i].vs0 = ldg8(Vg + (size_t)(k0_ + sr) * LDK + sc); st_[i].vs1 = ldg8(Vg + (size_t)(k0_ + 32 + sr) * LDK + sc); \
        st_[i].ks0 = ldg8(Kg + (size_t)(k0_ + sr) * LDK + sc); st_[i].ks1 = ldg8(Kg + (size_t)(k0_ + 32 + sr) * LDK + sc); \
        if constexpr (MODE == 1) st_[i].kp0 = ldg8(A.KR + (size_t)(k0_ + pr) * 64 + pc); } while (0)
#define ATT_SWRITE(bb, i) do { *(LAS bf16x8*)(lds + L_V + (bb) * SHM_V + vst0) = st_[i].vs0; *(LAS bf16x8*)(lds + L_V + (bb) * SHM_V + vst1) = st_[i].vs1; \
        *(LAS bf16x8*)(lds + L_K + (bb) * SHM_K + kst0) = st_[i].ks0; *(LAS bf16x8*)(lds + L_K + (bb) * SHM_K + kst1) = st_[i].ks1; \
        if constexpr (MODE == 1) *(LAS bf16x8*)(lds + L_KP + (bb) * SHM_KP + pst) = st_[i].kp0; } while (0)
#define ATT_SWAIT() do { if constexpr (SD == 2) asm volatile("s_waitcnt vmcnt(4)" ::: "memory"); else asm volatile("s_waitcnt vmcnt(0)" ::: "memory"); } while (0)
    LAS float* wsf = (LAS float*)(lds + L_WS) + wid * 64; LAS float* li_l = wsf; LAS float* al_l = wsf + 32;
#define ATT_RESC(a) do { if (__any((a) < 1.f)) { if (hi == 0) al_l[r32] = (a); asm volatile("s_waitcnt lgkmcnt(0)" ::: "memory"); \
        _Pragma("unroll") for (int d = 0; d < 4; ++d) _Pragma("unroll") for (int r = 0; r < 16; ++r) o[d][r] *= al_l[crow(r, hi)]; } } while (0)
    const int vb0 = (int)(uintptr_t)(lds + L_V) + v_rd_base(lane);
    const lptr K0 = lds + L_K, K1 = lds + L_K + SHM_K, P0 = lds + L_KP, P1 = lds + L_KP + SHM_KP;
    float m_reg = -1e30f, l_reg = 0.f; f32x16 o[4];
#pragma unroll
    for (int d = 0; d < 4; ++d) o[d] = f32x16{};
    f32x16 pA0, pA1, pB0, pB1; float mnA, mnB, alA, alB; bf16x8 pa0, pa1, pa2, pa3;
    constexpr int SE = 0, SO = SD - 1;
    ATT_SLOAD(SE, 0); asm volatile("s_waitcnt vmcnt(0)" ::: "memory"); ATT_SWRITE(0, SE); __syncthreads();
    qkt2<MODE>(pA0, pA1, K0, P0, qr, qpl, comp, r32, hi); partial_sm<MODE>(pA0, pA1, m_reg, mnA, alA);
    ATT_SLOAD(SO, 1); if constexpr (SD == 2) { if (2 < NT) ATT_SLOAD(SE, 2); }
    ATT_SWAIT(); ATT_SWRITE(1, SO); __syncthreads();
    for (int j = 1; j + 1 < NT; j += 2) {
        ATT_SBAR(); qkt2<MODE>(pB0, pB1, K1, P1, qr, qpl, comp, r32, hi);
        finish_sm(pA0, pA1, alA, l_reg, pa0, pa1, pa2, pa3); ATT_SBAR();
        ATT_SLOAD(SO, j + SD); ATT_SBAR();
        pv_d0(o, vb0, pa0, pa1, pa2, pa3); partial_sm<MODE>(pB0, pB1, m_reg, mnB, alB);
        __syncthreads(); ATT_SWAIT(); ATT_SWRITE(0, SE);
        ATT_RESC(alB); __syncthreads();
        ATT_SBAR(); qkt2<MODE>(pA0, pA1, K0, P0, qr, qpl, comp, r32, hi);
        finish_sm(pB0, pB1, alB, l_reg, pa0, pa1, pa2, pa3); ATT_SBAR();
        if (SD == 1 || j + 3 < NT) ATT_SLOAD(SE, j + 1 + SD); ATT_SBAR();
        pv_d0(o, vb0 + SHM_V, pa0, pa1, pa2, pa3); partial_sm<MODE>(pA0, pA1, m_reg, mnA, alA);
        __syncthreads(); ATT_SWAIT(); ATT_SWRITE(1, SO);
        ATT_RESC(alA); __syncthreads();
    }
    ATT_SBAR(); qkt2<MODE>(pB0, pB1, K1, P1, qr, qpl, comp, r32, hi);
    finish_sm(pA0, pA1, alA, l_reg, pa0, pa1, pa2, pa3); ATT_SBAR();
    pv_d0(o, vb0, pa0, pa1, pa2, pa3); partial_sm<MODE>(pB0, pB1, m_reg, mnB, alB);
    __syncthreads(); ATT_RESC(alB);
    finish_sm(pB0, pB1, alB, l_reg, pa0, pa1, pa2, pa3); ATT_SBAR();
    pv_d0(o, vb0 + SHM_V, pa0, pa1, pa2, pa3);
    if (hi == 0) li_l[r32] = l_reg; asm volatile("s_waitcnt lgkmcnt(0)" ::: "memory");
    float rli[16];
#pragma unroll
    for (int r = 0; r < 16; ++r) rli[r] = 1.0f / li_l[crow(r, hi)];
    asm volatile("s_waitcnt lgkmcnt(0)" ::: "memory");
    if constexpr (MODE == 1) {
        bf16* Yp = A.Y + (size_t)qrow0 * 2048 + 1024 + h * 128 + r32;
#pragma unroll
        for (int r = 0; r < 16; ++r) { const int orow = crow(r, hi);
#pragma unroll
            for (int d = 0; d < 4; ++d) Yp[(size_t)orow * 2048 + d * 32] = (bf16)f2bf(o[d][r] * rli[r]); }
        __syncthreads();
    } else {
        LAS float* xch = (LAS float*)lds;
        __syncthreads();
        if (comp == 1) {
#pragma unroll
            for (int d = 0; d < 4; ++d)
#pragma unroll
                for (int r = 0; r < 16; ++r) xch[(wq * 64 + d * 16 + r) * 64 + lane] = A.lam * (o[d][r] * rli[r]);
        }
        __syncthreads();
        if (comp == 0) {
            bf16* Yp = A.Y + (size_t)qrow0 * 2048 + h * 128 + r32;
            float g[4];
#pragma unroll
            for (int d = 0; d < 4; ++d) g[d] = A.subln[d * 32 + r32] * A.omli;
#pragma unroll
            for (int r = 0; r < 16; ++r) { float v[4]; float ss = 0.f;
#pragma unroll
                for (int d = 0; d < 4; ++d) { v[d] = o[d][r] * rli[r] - xch[(wq * 64 + d * 16 + r) * 64 + lane]; ss += v[d] * v[d]; }
                ss += __shfl_xor(ss, 1); ss += __shfl_xor(ss, 2); ss += __shfl_xor(ss, 4); ss += __shfl_xor(ss, 8); ss += __shfl_xor(ss, 16);
                const float rs = 1.0f / sqrtf(ss * (1.0f / 128.0f) + EPS); const int orow = crow(r, hi);
#pragma unroll
                for (int d = 0; d < 4; ++d) Yp[(size_t)orow * 2048 + d * 32] = (bf16)f2bf(v[d] * rs * g[d]); }
        }
        __syncthreads();
    }
#undef ATT_KROW
#undef ATT_SLOAD
#undef ATT_SWRITE
#undef ATT_SWAIT
#undef ATT_RESC
}
#undef ATT_SBAR
}
struct Args {
    const float *x, *c, *ctx, *c_ctx, *w_ada, *b_ada, *norm1_g, *norm2_g, *w_in, *b_gate, *q_a_norm, *w_uq, *kv_a_norm, *w_ukv, *diff_lambda, *diff_subln,
                *w_o_diff, *w_o_mla, *w_out, *w_mlp1, *w_mlp2, *final_norm_g;
    float* out; unsigned char* ws; int ph_lo, ph_hi;
};
constexpr int NPHASE = 2 + 9 * DEPTH;
constexpr int NWAVES = 8;

constexpr int IT_IN = 32 * 256, IT_UQ = 8 * 48, IT_UKV = 4 * 64, IT_OD = 16 * 64, IT_OM = 16 * 64, IT_OUT = 32 * 64, IT_1 = 32 * 256, IT_2 = 128 * 64;
constexpr int IT_LAYER = IT_IN + IT_UQ + IT_UKV + IT_OD + IT_OM + IT_OUT + IT_1 + IT_2;
struct P0Desc { const float* src; const float* gain; bf16* dst; int ldw, ldt; bool zero; };
__device__ __forceinline__ P0Desc p0_decode(const Args& a, bf16* WB, int it) {
    const int l = it / IT_LAYER; int r = it % IT_LAYER; bf16* Wl = WB + (size_t)l * W_LAYER; P0Desc d; d.gain = nullptr; d.zero = false;
#define P0_SET(W_, ldw_, k0_, src_, dstp_, ldt_, drow_, dk_) do { d.src = (W_) + (size_t)(k0_) * (ldw_) + (src_); d.ldw = (ldw_); d.dst = (dstp_) + (size_t)(drow_) * (ldt_) + (dk_); d.ldt = (ldt_); } while (0)
    if (r < IT_IN) { const int kb = r / 256, nb = r % 256; const int src = nb < 122 ? nb * 32 : (nb < 128 ? 0 : (nb - 6) * 32); d.zero = (nb >= 122 && nb < 128);
        P0_SET(a.w_in + (size_t)l * DM * 8000, 8000, kb * 64, src, Wl + W_IN, DM, nb * 32, kb * 64); return d; } r -= IT_IN;
    if (r < IT_UQ) { const int kb = r / 48, nb = r % 48; const int src = nb < 32 ? (nb >> 2) * 192 + (nb & 3) * 32 : ((nb - 32) >> 1) * 192 + 128 + ((nb - 32) & 1) * 32;
        P0_SET(a.w_uq + (size_t)l * 512 * 1536, 1536, kb * 64, src, Wl + W_UQ, 512, nb * 32, kb * 64); d.gain = a.q_a_norm + l * 512 + kb * 64; return d; } r -= IT_UQ;
    if (r < IT_UKV) { const int kb = r / 64, nb = r % 64; const int src = nb < 32 ? (nb >> 2) * 256 + (nb & 3) * 32 : ((nb - 32) >> 2) * 256 + 128 + ((nb - 32) & 3) * 32;
        P0_SET(a.w_ukv + (size_t)l * 256 * 2048, 2048, kb * 64, src, Wl + W_UKV, 256, nb * 32, kb * 64); d.gain = a.kv_a_norm + l * 256 + kb * 64; return d; } r -= IT_UKV;
    if (r < IT_OD) { const int kb = r / 64, nb = r % 64; P0_SET(a.w_o_diff + (size_t)l * 1024 * DM, DM, kb * 64, nb * 32, Wl + W_O, 2048, nb * 32, kb * 64); return d; } r -= IT_OD;
    if (r < IT_OM) { const int kb = r / 64, nb = r % 64; P0_SET(a.w_o_mla + (size_t)l * 1024 * DM, DM, kb * 64, nb * 32, Wl + W_O, 2048, nb * 32, 1024 + kb * 64); return d; } r -= IT_OM;
    if (r < IT_OUT) { const int kb = r / 64, nb = r % 64; P0_SET(a.w_out + (size_t)l * DM * DM, DM, kb * 64, nb * 32, Wl + W_OUT, DM, nb * 32, kb * 64); return d; } r -= IT_OUT;
    if (r < IT_1) { const int kb = r / 256, nb = r % 256; P0_SET(a.w_mlp1 + (size_t)l * DM * DFF, DFF, kb * 64, nb * 32, Wl + W_1, DM, nb * 32, kb * 64); return d; } r -= IT_1;
    { const int kb = r / 64, nb = r % 64; P0_SET(a.w_mlp2 + (size_t)l * DFF * DM, DM, kb * 64, nb * 32, Wl + W_2, DFF, nb * 32, kb * 64); return d; }
#undef P0_SET
}
__device__ __forceinline__ void p0_load(const P0Desc& d, float (&v)[32], int lane) {
    const float* wp = d.src + (size_t)(lane >> 5) * d.ldw + (lane & 31); const size_t st2 = (size_t)2 * d.ldw;
#pragma unroll
    for (int i = 0; i < 32; ++i) v[i] = wp[i * st2];
}
__device__ __forceinline__ void p0_store(const P0Desc& d, float (&v)[32], LAS float* scr, int lane) {
    if (d.gain) {
#pragma unroll
        for (int i = 0; i < 32; ++i) v[i] *= d.gain[2 * i + (lane >> 5)]; }
    if (d.zero) {
#pragma unroll
        for (int i = 0; i < 32; ++i) v[i] = 0.f; }
#pragma unroll
    for (int i = 0; i < 32; ++i) scr[(2 * i + (lane >> 5)) * 33 + (lane & 31)] = v[i];
    LDS_WAIT(); asm volatile("" ::: "memory");
    const int c = lane & 7;
#pragma unroll
    for (int j = 0; j < 4; ++j) { const int n = (lane >> 3) + 8 * j; const LAS float* s = scr + (8 * c) * 33 + n;
        v4u o; o.x = pk2(s[0 * 33], s[1 * 33]); o.y = pk2(s[2 * 33], s[3 * 33]); o.z = pk2(s[4 * 33], s[5 * 33]); o.w = pk2(s[6 * 33], s[7 * 33]);
        *(GAS v4u*)(d.dst + (size_t)n * d.ldt + 8 * c) = o; }
    LDS_WAIT(); asm volatile("" ::: "memory");
}
__device__ __forceinline__ void p0_weights(const Args& a, bf16* WB, LAS unsigned char* lds, int gw, int NGW, int wave, int lane) {
    LAS float* scr = (LAS float*)(lds + wave * 16384);
    constexpr int NIT = DEPTH * IT_LAYER;
    for (int it = gw; it < NIT; it += 2 * NGW) {
        const bool two = (it + NGW) < NIT;
        const P0Desc d0 = p0_decode(a, WB, it), d1 = p0_decode(a, WB, two ? it + NGW : it);
        float v0[32], v1[32];
        p0_load(d0, v0, lane); p0_load(d1, v1, lane);
        p0_store(d0, v0, scr, lane);
        if (two) p0_store(d1, v1, scr, lane);
    }
}
__device__ __forceinline__ void p0_rope(float* rope, int gtid, int nthreads) {
    for (int e = gtid; e < SEQ * 32; e += nthreads) { const int t = e >> 5, i = e & 31; const float f = powf(10000.0f, -(float)(2 * (i & 15)) / 32.0f);
        const float ang = (float)((i < 16) ? (t >> 6) : (t & 63)) * f; rope[2 * e] = cosf(ang); rope[2 * e + 1] = sinf(ang); }
}
__device__ __forceinline__ void p0_mod(const Args& a, float* MOD, LAS unsigned char* lds, int vcu, int G, int tid, int wave, int lane) {
    LAS float* S = (LAS float*)lds;
    LAS float* P = (LAS float*)(lds + 17 * 2048 * 4);
    for (int e = tid; e < 17 * 2048; e += NWAVES * 64) { const float v = (e < 16 * 2048) ? a.c[e] : a.c_ctx[e - 16 * 2048]; S[e] = v / (1.0f + expf(-v)); }
    __syncthreads();
    for (int u = vcu; u < DEPTH * 192; u += G) {
        const int l = u / 192, col = (u % 192) * 64 + lane; const float* wp = a.w_ada + (size_t)l * DM * NMOD + col;
        float acc[17];
#pragma unroll
        for (int b = 0; b < 17; ++b) acc[b] = 0.f;
        for (int k = wave * 256; k < wave * 256 + 256; k += 16) {
            float w[16];
#pragma unroll
            for (int i = 0; i < 16; ++i) w[i] = wp[(size_t)(k + i) * NMOD];
#pragma unroll
            for (int q = 0; q < 4; ++q) {
#pragma unroll
                for (int b = 0; b < 17; ++b) { const f32x4 s = *(const LAS f32x4*)(S + b * 2048 + k + 4 * q); acc[b] += (s[0] * w[4 * q] + s[1] * w[4 * q + 1]) + (s[2] * w[4 * q + 2] + s[3] * w[4 * q + 3]); }
                asm volatile("" ::: "memory"); }
        }
        LAS float* Pl = P + lane; asm volatile("" : "+v"(Pl));
        LAS float* Pw = Pl + (wave & 3) * (17 * 64);
        if (wave >= 4) {
#pragma unroll
            for (int b = 0; b < 17; ++b) Pw[b * 64] = acc[b];
        }
        __syncthreads();
        if (wave < 4) {
#pragma unroll
            for (int b = 0; b < 17; ++b) { acc[b] += Pw[b * 64]; Pw[b * 64] = acc[b]; }
        }
        __syncthreads();
        if (wave == 0) { const float bias = a.b_ada[l * NMOD + col];
#pragma unroll
            for (int b = 0; b < 17; ++b) MOD[((size_t)l * 17 + b) * NMOD + col] = ((Pl[(0 * 17 + b) * 64] + Pl[(1 * 17 + b) * 64]) + (Pl[(2 * 17 + b) * 64] + Pl[(3 * 17 + b) * 64])) + bias;
        }
        __syncthreads();
    }
}
__device__ __forceinline__ void norm_mod_row(const float* xrow, const float* g, const float* shift, const float* scale, bf16* orow, int lane, float* wb = nullptr, const float* p0 = nullptr, const float* p1 = nullptr) {
    const GAS f32x4* xr = (const GAS f32x4*)xrow + lane; f32x4 v[8]; float s = 0.f;
    if (wb) {
#pragma unroll
        for (int j = 0; j < 8; ++j) { v[j] = xr[64 * j] + ((const GAS f32x4*)p0 + lane)[64 * j] + ((const GAS f32x4*)p1 + lane)[64 * j]; ((GAS f32x4*)wb + lane)[64 * j] = v[j]; }
    } else {
#pragma unroll
        for (int j = 0; j < 8; ++j) v[j] = xr[64 * j];
    }
#pragma unroll
    for (int j = 0; j < 8; ++j) s += (v[j].x * v[j].x + v[j].y * v[j].y) + (v[j].z * v[j].z + v[j].w * v[j].w);
    const float rstd = 1.0f / sqrtf(wave_sum(s) * (1.0f / DM) + EPS);
    GAS v2u* o8 = (GAS v2u*)orow + lane;
#pragma unroll
    for (int j = 0; j < 8; ++j) { const int c = 4 * (lane + 64 * j); const f32x4 gg = *(const f32x4*)(g + c), sh = *(const f32x4*)(shift + c), sc = *(const f32x4*)(scale + c);
        const f32x4 y = (v[j] * rstd) * gg * (sc + 1.0f) + sh; v2u w; w.x = pk2(y.x, y.y); w.y = pk2(y.z, y.w); o8[64 * j] = w; }
}
__device__ __forceinline__ void final_norm_row(float* xrow, const float* g, int lane) {
    GAS f32x4* xr = (GAS f32x4*)xrow + lane; f32x4 v[8]; float s = 0.f;
#pragma unroll
    for (int j = 0; j < 8; ++j) { v[j] = xr[64 * j]; s += (v[j].x * v[j].x + v[j].y * v[j].y) + (v[j].z * v[j].z + v[j].w * v[j].w); }
    const float rstd = 1.0f / sqrtf(wave_sum(s) * (1.0f / DM) + EPS);
#pragma unroll
    for (int j = 0; j < 8; ++j) { const f32x4 gg = *(const f32x4*)(g + 4 * (lane + 64 * j)); xr[64 * j] = (v[j] * rstd) * gg; }
}

__global__ void __launch_bounds__(NWAVES * 64, 2) mk_fwd(Args a) {
    extern __shared__ __attribute__((aligned(16))) unsigned char lds_raw[];
    LAS unsigned char* lds = (LAS unsigned char*)lds_raw;
    volatile LAS unsigned* MISC = (volatile LAS unsigned*)(lds + MISC_OFF);
    const int tid = threadIdx.x, lane = tid & 63, wave = __builtin_amdgcn_readfirstlane(tid >> 6);
    const int G = gridDim.x; const int bx = blockIdx.x; const int vcu = (G % 8 == 0) ? (bx % 8) * (G / 8) + bx / 8 : bx;
    const int gw = vcu * NWAVES + wave, NGW = G * NWAVES;
    unsigned char* ws = a.ws;
    gu32* ctl = (gu32*)(ws + WS_CTL);
    float* MOD = (float*)(ws + WS_MOD); float* ROPE = (float*)(ws + WS_ROPE); float* SSQ = (float*)(ws + WS_SSQ);
    bf16* WB = (bf16*)(ws + WS_W); float* XC = (float*)(ws + WS_XC); bf16* HB = (bf16*)(ws + WS_HB); float* PART = (float*)(ws + WS_PART);
    unsigned char* big = ws + WS_BIG;
    bf16 *QD = (bf16*)(big + B_QD), *KD = (bf16*)(big + B_KD), *VD = (bf16*)(big + B_VD), *CQ = (bf16*)(big + B_CQ), *CKV = (bf16*)(big + B_CKV), *KR = (bf16*)(big + B_KR),
         *GT = (bf16*)(big + B_G), *QM = (bf16*)(big + B_QM), *KVM = (bf16*)(big + B_KVM), *MG = (bf16*)(big + B_MG), *UB = (bf16*)(big + B_U);
    for (int u = tid; u < 64; u += NWAVES * 64) MISC[u] = 0u;
    __syncthreads();
#if MK_MULTI
#define SEAM(k) do { } while (0)
#else
    XcdBarrier bar = xcd_barrier_post((unsigned*)(ctl + CW_BAR), MISC + 8);
#define SEAM(k) do { if ((k) + 1 < hi) xcd_barrier(bar); } while (0)
#endif
    const int lo = a.ph_lo, hi = a.ph_hi;
#define IN(k) (lo <= (k) && (k) < hi)
#define OPAQUE_IDS() int t_ = threadIdx.x; asm volatile("" : "+v"(t_)); const int lane_ = t_ & 63, gw_ = vcu * NWAVES + __builtin_amdgcn_readfirstlane(t_ >> 6); (void)lane_; (void)gw_
#ifndef MK_MASK
#define MK_MASK 0xFFFF
#endif
#define PH(i) if constexpr (((MK_MASK) >> (i)) & 1)

    PH(0) if (IN(0)) {
#ifndef MK_REP_P
#define MK_REP_P 1
#endif
        for (int rep = 0; rep < MK_REP_P; ++rep) {
        p0_weights(a, WB, lds, gw, NGW, wave, lane);
        p0_rope(ROPE, vcu * NWAVES * 64 + tid, G * NWAVES * 64);
        __syncthreads();
#ifndef MK_REP_M
#define MK_REP_M 1
#endif
        for (int rm = 0; rm < MK_REP_M; ++rm) { p0_mod(a, MOD, lds, vcu, G, tid, wave, lane); __syncthreads(); }
        }
        SEAM(0);
    }
    for (int l = 0; l < DEPTH; ++l) {
        const int pb = 1 + 9 * l;
        const bf16* Wl = WB + (size_t)l * W_LAYER;
        const float* modl = MOD + (size_t)l * 17 * NMOD;
        const float* xsrc = (l == 0) ? a.x : a.out;
        const float* csrc = (l == 0) ? a.ctx : XC;
        const bool lastl = (l == DEPTH - 1);
        const int Mact = lastl ? MLAT : MTOT;
        PH(1) if (IN(pb + 0)) {
            OPAQUE_IDS();
#ifndef MK_REP_N
#define MK_REP_N 1
#endif
            for (int rep = 0; rep < MK_REP_N; ++rep)
            for (int m = gw_; m < MTOT; m += NGW) {
                const bool lat = m < MLAT; const float* xr = lat ? xsrc + (size_t)m * DM : csrc + (size_t)(m - MLAT) * DM; const float* mr = modl + (size_t)(lat ? (m >> 11) : 16) * NMOD;
                if (!lat && l > 0) { float* xw = XC + (size_t)(m - MLAT) * DM; const float* pp = PART + (size_t)(m - MLAT) * DM;
                    norm_mod_row(xr, a.norm1_g + l * DM, mr, mr + DM, HB + (size_t)m * DM, lane_, xw, pp, pp + (size_t)MCTX * DM); }
                else norm_mod_row(xr, a.norm1_g + l * DM, mr, mr + DM, HB + (size_t)m * DM, lane_);
            }
            SEAM(pb + 0);
        }
        PH(2) if (IN(pb + 1)) {
            pg8::Gemm g{HB, Wl + W_IN, MTOT, NIN, DM}; pg8::StaticOrder S; S.init(MTOT, NIN, G, bx);
            pg8::EpiInProj E{QD, KD, VD, CQ, CKV, KR, GT, SSQ, a.b_gate + l * 4096, ROPE};
#ifndef MK_REP_B
#define MK_REP_B 1
#endif
            for (int rep = 0; rep < MK_REP_B; ++rep) pg8::gemm_phase<pg8::EpiInProj, pg8::StaticOrder, true, true>(lds, g, S, E);
            SEAM(pb + 1);
        }
        PH(3) if (IN(pb + 2)) {
            { pg8::Gemm g{CQ, Wl + W_UQ, MTOT, 1536, 512}; pg8::StaticOrder S; S.init(MTOT, 1536, G, bx);
              pg8::EpiUp<true> E{QM, SSQ, ROPE}; pg8::gemm_phase<pg8::EpiUp<true>, pg8::StaticOrder, true, true>(lds, g, S, E); }
            { pg8::Gemm g{CKV, Wl + W_UKV, MTOT, 2048, 256}; pg8::StaticOrder S; S.init(MTOT, 2048, G, bx);
              pg8::EpiUp<false> E{KVM, SSQ, ROPE}; pg8::gemm_phase<pg8::EpiUp<false>, pg8::StaticOrder, true, true>(lds, g, S, E); }
            SEAM(pb + 2);
        }
        PH(4) if (IN(pb + 3)) {
            OPAQUE_IDS();
            const float* dl = a.diff_lambda + l * 256;
            const float sa = wave_sum(dl[lane_] * dl[64 + lane_]), sb = wave_sum(dl[128 + lane_] * dl[192 + lane_]);
            const float lam_init = 0.8f - 0.6f * expf(-0.3f * (float)l);
            att::Args A{QD, KD, VD, QM, KVM, KR, HB, a.diff_subln + l * 128, expf(sa) - expf(sb) + lam_init, 1.0f - lam_init};
            const int n0 = lastl ? 2048 : 2048 + 256, n1 = lastl ? 1024 : 1024 + 128;
#ifndef ATT_UNIT
#define ATT_UNIT attn_unit2
#endif
#ifndef MK_REP_D
#define MK_REP_D 1
#endif
            for (int rep = 0; rep < MK_REP_D; ++rep) {
            for (int u = vcu; u < n0; u += G) { const bool isctx = u >= 2048; const int v = isctx ? u - 2048 : u; const int qb = isctx ? (v & 1) : (v & 15), bh = isctx ? (v >> 1) : (v >> 4);
                att::ATT_UNIT<0>(A, bh >> 3, bh & 7, qb, isctx, (att::lptr)lds); }
            for (int u = vcu; u < n1; u += G) { const bool isctx = u >= 1024; const int v = isctx ? u - 1024 : u; const int qb = isctx ? 0 : (v & 7), bh = isctx ? v : (v >> 3);
                att::ATT_UNIT<1>(A, bh >> 3, bh & 7, qb, isctx, (att::lptr)lds); }
            }
            SEAM(pb + 3);
        }
        PH(5) if (IN(pb + 4)) {
            pg8::Gemm g{HB, Wl + W_O, Mact, DM, DM}; pg8::StaticOrder S; S.init(Mact, DM, G, bx);
            pg8::EpiMerge E{MG, GT}; pg8::gemm_phase<pg8::EpiMerge, pg8::StaticOrder, true, true>(lds, g, S, E);
            SEAM(pb + 4);
        }
        PH(6) if (IN(pb + 5)) {
            pg8::Gemm g{MG, Wl + W_OUT, Mact, DM, DM}; pg8::StaticOrder S; S.init(Mact, DM, G, bx);
            pg8::EpiResid E{a.out, xsrc, XC, csrc, modl + 2 * DM, PART}; pg8::gemm_phase<pg8::EpiResid, pg8::StaticOrder, true, true>(lds, g, S, E);
            SEAM(pb + 5);
        }
        PH(7) if (IN(pb + 6)) {
            OPAQUE_IDS();
            for (int rep = 0; rep < MK_REP_N; ++rep)
            for (int m = gw_; m < Mact; m += NGW) {
                const bool lat = m < MLAT; const float* xr = lat ? a.out + (size_t)m * DM : XC + (size_t)(m - MLAT) * DM; const float* mr = modl + (size_t)(lat ? (m >> 11) : 16) * NMOD;
                norm_mod_row(xr, a.norm2_g + l * DM, mr + 3 * DM, mr + 4 * DM, HB + (size_t)m * DM, lane_);
            }
            SEAM(pb + 6);
        }
        PH(8) if (IN(pb + 7)) {
            pg8::Gemm g{HB, Wl + W_1, Mact, DFF, DM}; pg8::StaticOrder S; S.init(Mact, DFF, G, bx);
#ifndef MK_REP_H
#define MK_REP_H 1
#endif
            pg8::EpiRelu2 E{UB}; for (int rep = 0; rep < MK_REP_H; ++rep) pg8::gemm_phase<pg8::EpiRelu2, pg8::StaticOrder, true, true>(lds, g, S, E);
            SEAM(pb + 7);
        }
        PH(9) if (IN(pb + 8)) {
            pg8::Gemm g{UB, Wl + W_2, Mact, DM, DFF}; pg8::TailSplitOrder S; S.init(MLAT, Mact, DM, DFF, G, bx);
            pg8::EpiResid E{a.out, a.out, XC, XC, modl + 5 * DM, PART}; pg8::gemm_phase<pg8::EpiResid, pg8::TailSplitOrder, true, true>(lds, g, S, E);
            SEAM(pb + 8);
        }
    }
    PH(10) if (IN(NPHASE - 1)) {
        OPAQUE_IDS();
        for (int m = gw_; m < MLAT; m += NGW) final_norm_row(a.out + (size_t)m * DM, a.final_norm_g, lane_);
    }
#undef IN
#undef SEAM
}
#if MK_DEBUG
constexpr int DBG_NS = 48;
__host__ __device__ inline int dbg_row(int s) { return (s * 577 + 13) % MTOT; }
__device__ inline void dbg_upd(float* err, float got, float ref, float sc) {
    float e = fabsf(got - ref) / (fabsf(ref) + sc); if (!(e == e) || !(got == got)) e = 1e9f;
    atomicMax((unsigned*)err, __float_as_uint(e));
}
__device__ inline float dbg_b(const bf16* p, size_t i) { return bf2f((unsigned)p[i]); }
__device__ inline void dbg_rope_cs(int t, int d, float& cs, float& sn) {
    const float f = powf(10000.0f, -(float)(2 * (d & 15)) / 32.0f); const float ang = (float)((d < 32) ? (t >> 6) : (t & 63)) * f; cs = cosf(ang); sn = sinf(ang);
}
struct DbgP { Args a; int l; int pad; float* err; };

__global__ void __launch_bounds__(256) dbg_mod(DbgP p) {
    const int l = blockIdx.x / 17, bb = blockIdx.x % 17, j = (threadIdx.x * 37 + 5) % NMOD; const float* cv = bb < 16 ? p.a.c + bb * DM : p.a.c_ctx;
    float acc = 0.f; for (int k = 0; k < DM; ++k) { const float v = cv[k]; acc += (v / (1.0f + expf(-v))) * p.a.w_ada[((size_t)l * DM + k) * NMOD + j]; }
    acc += p.a.b_ada[l * NMOD + j];
    dbg_upd(p.err, ((const float*)(p.a.ws + WS_MOD))[((size_t)l * 17 + bb) * NMOD + j], acc, 0.1f);
}
__global__ void __launch_bounds__(256) dbg_snap(const float* xs, const float* cs, float* snap) {
    const int m = dbg_row(blockIdx.x); const float* r = m < MLAT ? xs + (size_t)m * DM : cs + (size_t)(m - MLAT) * DM;
    for (int c = threadIdx.x; c < DM; c += 256) snap[(size_t)blockIdx.x * DM + c] = r[c];
}
__global__ void __launch_bounds__(256) dbg_norm(DbgP p, const float* xs, const float* cs, const float* g, int shoff, int scoff, int mact) {
    __shared__ float red[256];
    const int m = dbg_row(blockIdx.x); if (m >= mact) return; const float* r = m < MLAT ? xs + (size_t)m * DM : cs + (size_t)(m - MLAT) * DM;
    float s = 0.f; for (int c = threadIdx.x; c < DM; c += 256) s += r[c] * r[c];
    red[threadIdx.x] = s; __syncthreads(); for (int o = 128; o > 0; o >>= 1) { if ((int)threadIdx.x < o) red[threadIdx.x] += red[threadIdx.x + o]; __syncthreads(); }
    const float rstd = 1.0f / sqrtf(red[0] / DM + EPS); const float* mr = (const float*)(p.a.ws + WS_MOD) + ((size_t)p.l * 17 + (m < MLAT ? (m >> 11) : 16)) * NMOD;
    const bf16* H = (const bf16*)(p.a.ws + WS_HB);
    for (int c = threadIdx.x; c < DM; c += 256) { const float ref = r[c] * rstd * g[c] * (1.0f + mr[scoff + c]) + mr[shoff + c]; dbg_upd(p.err, dbg_b(H, (size_t)m * DM + c), ref, 0.5f); }
}
__global__ void __launch_bounds__(256) dbg_final(DbgP p, const float* snap) {
    __shared__ float red[256];
    const int m = dbg_row(blockIdx.x); if (m >= MLAT) return; const float* r = snap + (size_t)blockIdx.x * DM;
    float s = 0.f; for (int c = threadIdx.x; c < DM; c += 256) s += r[c] * r[c];
    red[threadIdx.x] = s; __syncthreads(); for (int o = 128; o > 0; o >>= 1) { if ((int)threadIdx.x < o) red[threadIdx.x] += red[threadIdx.x + o]; __syncthreads(); }
    const float rstd = 1.0f / sqrtf(red[0] / DM + EPS);
    for (int c = threadIdx.x; c < DM; c += 256) dbg_upd(p.err, p.a.out[(size_t)m * DM + c], r[c] * rstd * p.a.final_norm_g[c], 0.5f);
}
__global__ void __launch_bounds__(256) dbg_inproj(DbgP p) {
    const int m = dbg_row(blockIdx.y), n = blockIdx.x * 256 + threadIdx.x; if (n >= 8000) return;
    const bf16* H = (const bf16*)(p.a.ws + WS_HB) + (size_t)m * DM; const float* W = p.a.w_in + (size_t)p.l * DM * 8000;
    unsigned char* big = p.a.ws + WS_BIG; const bool lat = m < MLAT; const int t = m & 2047;
    int grp = -1, d = 0;
    if (n < 2048) { grp = 0; d = n & 63; } else if (n >= 3840 && n < 3904) { grp = 1; d = n - 3840; }
    const bool rot = (grp >= 0) && lat; const int np = rot ? (((d & 31) < 16) ? n + 16 : n - 16) : n;
    float acc = 0.f, accp = 0.f;
    for (int k = 0; k < DM; ++k) { const float h = bf2f((unsigned)H[k]); acc += h * W[(size_t)k * 8000 + n]; if (rot) accp += h * W[(size_t)k * 8000 + np]; }
    float v = acc;
    if (rot) { float cs, sn; dbg_rope_cs(t, d, cs, sn); v = acc * cs + (((d & 31) < 16) ? -accp : accp) * sn; }
    if (n < 1024) dbg_upd(p.err + 0, dbg_b((const bf16*)(big + B_QD), (size_t)m * 1024 + n), 0.125f * v, 0.06f);
    else if (n < 2048) dbg_upd(p.err + 1, dbg_b((const bf16*)(big + B_KD), (size_t)m * 1024 + n - 1024), v, 0.5f);
    else if (n < 3072) dbg_upd(p.err + 2, dbg_b((const bf16*)(big + B_VD), (size_t)m * 1024 + n - 2048), v, 0.5f);
    else if (n < 3584) dbg_upd(p.err + 3, dbg_b((const bf16*)(big + B_CQ), (size_t)m * 512 + n - 3072), v, 0.5f);
    else if (n < 3840) dbg_upd(p.err + 4, dbg_b((const bf16*)(big + B_CKV), (size_t)m * 256 + n - 3584), v, 0.5f);
    else if (n < 3904) dbg_upd(p.err + 5, dbg_b((const bf16*)(big + B_KR), (size_t)m * 64 + n - 3840), v, 0.5f);
    else dbg_upd(p.err + 6, dbg_b((const bf16*)(big + B_G), (size_t)m * 4096 + n - 3904), 1.0f / (1.0f + expf(-(v + p.a.b_gate[p.l * 4096 + n - 3904]))), 0.3f);
}
__global__ void __launch_bounds__(256) dbg_up(DbgP p) {
    __shared__ float red[256]; __shared__ float rs2[2];
    const int m = dbg_row(blockIdx.y); unsigned char* big = p.a.ws + WS_BIG; const bool lat = m < MLAT; const int t = m & 2047;
    const bf16* CQ = (const bf16*)(big + B_CQ) + (size_t)m * 512; const bf16* CKV = (const bf16*)(big + B_CKV) + (size_t)m * 256;
    { float s = 0.f; for (int k = threadIdx.x; k < 512; k += 256) { const float v = bf2f((unsigned)CQ[k]); s += v * v; }
      red[threadIdx.x] = s; __syncthreads(); for (int o = 128; o > 0; o >>= 1) { if ((int)threadIdx.x < o) red[threadIdx.x] += red[threadIdx.x + o]; __syncthreads(); }
      if (threadIdx.x == 0) rs2[0] = 1.0f / sqrtf(red[0] / 512.0f + EPS); __syncthreads();
      const float v = bf2f((unsigned)CKV[threadIdx.x]); red[threadIdx.x] = v * v; __syncthreads(); for (int o = 128; o > 0; o >>= 1) { if ((int)threadIdx.x < o) red[threadIdx.x] += red[threadIdx.x + o]; __syncthreads(); }
      if (threadIdx.x == 0) rs2[1] = 1.0f / sqrtf(red[0] / 256.0f + EPS); __syncthreads(); }
    const int n0 = blockIdx.x * 256 + threadIdx.x; if (n0 >= 3584) return;
    if (n0 < 1536) { const int n = n0, h = n / 192, j = n % 192; const float* W = p.a.w_uq + (size_t)p.l * 512 * 1536; const float* g = p.a.q_a_norm + p.l * 512;
        const bool rot = lat && j >= 128; const int d = j - 128; const int np = rot ? (((d & 31) < 16) ? n + 16 : n - 16) : n;
        float acc = 0.f, accp = 0.f; for (int k = 0; k < 512; ++k) { const float c = bf2f((unsigned)CQ[k]) * rs2[0] * g[k]; acc += c * W[(size_t)k * 1536 + n]; if (rot) accp += c * W[(size_t)k * 1536 + np]; }
        float v = acc; if (rot) { float cs, sn; dbg_rope_cs(t, d, cs, sn); v = acc * cs + (((d & 31) < 16) ? -accp : accp) * sn; }
        const size_t loc = (size_t)m * 1536 + (j < 128 ? h * 128 + j : 1024 + h * 64 + d);
        dbg_upd(p.err + (j < 128 ? 0 : 1), dbg_b((const bf16*)(big + B_QM), loc), v, 0.5f);
    } else { const int n = n0 - 1536, h = n / 256, j = n % 256; const float* W = p.a.w_ukv + (size_t)p.l * 256 * 2048; const float* g = p.a.kv_a_norm + p.l * 256;
        float acc = 0.f; for (int k = 0; k < 256; ++k) acc += bf2f((unsigned)CKV[k]) * rs2[1] * g[k] * W[(size_t)k * 2048 + n];
        const size_t loc = (size_t)m * 2048 + (j < 128 ? h * 128 + j : 1024 + h * 128 + (j - 128));
        dbg_upd(p.err + (j < 128 ? 2 : 3), dbg_b((const bf16*)(big + B_KVM), loc), acc, 0.5f);
    }
}
__global__ void __launch_bounds__(256) dbg_attn(DbgP p, int lastl) {
    __shared__ float s1[2304], s2[2304], red[256], q[256];
    const int m = dbg_row(blockIdx.y), h = blockIdx.x, tid = threadIdx.x; const bool lat = m < MLAT; if (!lat && lastl) return;
    unsigned char* big = p.a.ws + WS_BIG; const bf16 *QD = (const bf16*)(big + B_QD), *KD = (const bf16*)(big + B_KD), *VD = (const bf16*)(big + B_VD), *QM = (const bf16*)(big + B_QM), *KVM = (const bf16*)(big + B_KVM), *KR = (const bf16*)(big + B_KR);
    const bf16* Y = (const bf16*)(p.a.ws + WS_HB);
    const int b = lat ? (m >> 11) : ((m - MLAT) >> 8); const int nk = lat ? 2304 : 256;
    const float* dl = p.a.diff_lambda + p.l * 256; float sa = 0.f, sb = 0.f; for (int i = 0; i < 64; ++i) { sa += dl[i] * dl[64 + i]; sb += dl[128 + i] * dl[192 + i]; }
    const float lam_init = 0.8f - 0.6f * expf(-0.3f * (float)p.l), lam = expf(sa) - expf(sb) + lam_init;
#define DBG_KROW(k) ((k) < 256 ? MLAT + b * 256 + (k) : b * 2048 + (k) - 256)
#define DBG_BLOCKRED(OP, init) do { __syncthreads(); for (int o = 128; o > 0; o >>= 1) { if (tid < o) red[tid] = OP(red[tid], red[tid + o]); __syncthreads(); } } while (0)
    if (tid < 128) q[tid] = dbg_b(QD, (size_t)m * 1024 + h * 128 + tid);
    __syncthreads();
    for (int k = tid; k < nk; k += 256) { const size_t kr = (size_t)DBG_KROW(k) * 1024 + h * 128; float a1 = 0.f, a2 = 0.f;
        for (int d = 0; d < 64; ++d) { a1 += q[d] * dbg_b(KD, kr + d); a2 += q[64 + d] * dbg_b(KD, kr + 64 + d); } s1[k] = a1; s2[k] = a2; }
    __syncthreads();
#define DBG_ADD(x, y) ((x) + (y))
#define DBG_SOFTPV(sc, outv) do { float mx = -1e30f; for (int k = tid; k < nk; k += 256) mx = fmaxf(mx, sc[k]); red[tid] = mx; DBG_BLOCKRED(fmaxf, 0); mx = red[0]; __syncthreads(); \
        float sm = 0.f; for (int k = tid; k < nk; k += 256) { const float e = expf(sc[k] - mx); sc[k] = e; sm += e; } red[tid] = sm; \
        DBG_BLOCKRED(DBG_ADD, 0); sm = red[0]; __syncthreads(); \
        if (tid < 128) { float o = 0.f; for (int k = 0; k < nk; ++k) o += sc[k] * dbg_b(VD, (size_t)DBG_KROW(k) * 1024 + h * 128 + tid); outv = o / sm; } \
        __syncthreads(); } while (0)
    float o1 = 0.f, o2 = 0.f;
    DBG_SOFTPV(s1, o1); DBG_SOFTPV(s2, o2);
    { const float y = o1 - lam * o2; red[tid] = (tid < 128) ? y * y : 0.f; DBG_BLOCKRED(DBG_ADD, 0); const float rs = 1.0f / sqrtf(red[0] / 128.0f + EPS); __syncthreads();
      if (tid < 128) dbg_upd(p.err, dbg_b(Y, (size_t)m * 2048 + h * 128 + tid), y * rs * p.a.diff_subln[p.l * 128 + tid] * (1.0f - lam_init), 0.3f); }
    __syncthreads();
    if (tid < 128) q[tid] = dbg_b(QM, (size_t)m * 1536 + h * 128 + tid); else if (tid < 192) q[tid] = dbg_b(QM, (size_t)m * 1536 + 1024 + h * 64 + (tid - 128));
    __syncthreads();
    for (int k = tid; k < nk; k += 256) { const int kr = DBG_KROW(k); float a1 = 0.f;
        for (int d = 0; d < 128; ++d) a1 += q[d] * dbg_b(KVM, (size_t)kr * 2048 + h * 128 + d);
        for (int d = 0; d < 64; ++d) a1 += q[128 + d] * dbg_b(KR, (size_t)kr * 64 + d);
        s1[k] = a1 * MLA_SCALE; }
    __syncthreads();
    { float mx = -1e30f; for (int k = tid; k < nk; k += 256) mx = fmaxf(mx, s1[k]); red[tid] = mx; DBG_BLOCKRED(fmaxf, 0); mx = red[0]; __syncthreads();
      float sm = 0.f; for (int k = tid; k < nk; k += 256) { const float e = expf(s1[k] - mx); s1[k] = e; sm += e; } red[tid] = sm; DBG_BLOCKRED(DBG_ADD, 0); sm = red[0]; __syncthreads();
      if (tid < 128) { float o = 0.f; for (int k = 0; k < nk; ++k) o += s1[k] * dbg_b(KVM, (size_t)DBG_KROW(k) * 2048 + 1024 + h * 128 + tid);
          dbg_upd(p.err + 1, dbg_b(Y, (size_t)m * 2048 + 1024 + h * 128 + tid), o / sm, 0.02f); } }
}
__global__ void __launch_bounds__(256) dbg_merge(DbgP p, int mact) {
    const int m = dbg_row(blockIdx.y), n = blockIdx.x * 256 + threadIdx.x; if (m >= mact) return;
    const bf16* Y = (const bf16*)(p.a.ws + WS_HB) + (size_t)m * 2048; const bf16* G = (const bf16*)(p.a.ws + WS_BIG + B_G) + (size_t)m * 4096;
    const float* Wd = p.a.w_o_diff + (size_t)p.l * 1024 * DM; const float* Wm = p.a.w_o_mla + (size_t)p.l * 1024 * DM;
    float a1 = 0.f, a2 = 0.f; for (int k = 0; k < 1024; ++k) { a1 += bf2f((unsigned)Y[k]) * Wd[(size_t)k * DM + n]; a2 += bf2f((unsigned)Y[1024 + k]) * Wm[(size_t)k * DM + n]; }
    const float got = dbg_b((const bf16*)(p.a.ws + WS_BIG + B_MG), (size_t)m * 2048 + n), gd = bf2f((unsigned)G[n]), gm = bf2f((unsigned)G[2048 + n]);
    dbg_upd(p.err + 0, got, gd * a1 + gm * a2, 0.5f);
}
__global__ void __launch_bounds__(256) dbg_resid(DbgP p, const bf16* A, int K, const float* W, int goff, const float* snap, int mact) {
    const int m = dbg_row(blockIdx.y), n = blockIdx.x * 256 + threadIdx.x; if (m >= mact) return;
    float acc = 0.f; for (int k = 0; k < K; ++k) acc += bf2f((unsigned)A[(size_t)m * K + k]) * W[(size_t)k * DM + n];
    const float g = ((const float*)(p.a.ws + WS_MOD))[((size_t)p.l * 17 + (m < MLAT ? (m >> 11) : 16)) * NMOD + goff + n];
    const float got = m < MLAT ? p.a.out[(size_t)m * DM + n] : ((const float*)(p.a.ws + WS_XC))[(size_t)(m - MLAT) * DM + n];
    dbg_upd(p.err, got, snap[(size_t)blockIdx.y * DM + n] + g * acc, 0.5f);
}
__global__ void __launch_bounds__(256) dbg_mlp1(DbgP p, int mact) {
    const int m = dbg_row(blockIdx.y), n = blockIdx.x * 256 + threadIdx.x; if (m >= mact) return;
    const bf16* H = (const bf16*)(p.a.ws + WS_HB) + (size_t)m * DM; const float* W = p.a.w_mlp1 + (size_t)p.l * DM * DFF;
    float acc = 0.f; for (int k = 0; k < DM; ++k) acc += bf2f((unsigned)H[k]) * W[(size_t)k * DFF + n];
    acc = fmaxf(acc, 0.f); dbg_upd(p.err, dbg_b((const bf16*)(p.a.ws + WS_BIG + B_U), (size_t)m * DFF + n), acc * acc, 0.5f);
}
__global__ void __launch_bounds__(256) dbg_report(const float* err, float* out, int n) {
    int kf = -1;
    for (int k = 0; k < 96; ++k) { if (err[k] > 0.03f) { kf = k; break; } }
    if (kf < 0) return;
    if (kf == 40) {
        int hp = -1; for (int k = 41; k < 47; ++k) if (err[k] <= 0.03f) { hp = k; break; }
        const float f = hp >= 0 ? 0.5f : fminf(1.0f, err[40]); const size_t lim = (size_t)((double)f * (double)n); const float cval = 100.0f * (float)((hp >= 0 ? hp : 40) + 1);
        for (size_t i = (size_t)blockIdx.x * 256 + threadIdx.x; i < (size_t)n; i += (size_t)gridDim.x * 256) out[i] = (i < lim) ? cval : 0.0f;
        return;
    }
    int nf = 0; for (int k = (kf & ~7); k < (kf & ~7) + 8; ++k) nf += (err[k] > 0.03f) ? 1 : 0;
    const size_t lim = (size_t)n / 8 * (size_t)nf;
    for (size_t i = (size_t)blockIdx.x * 256 + threadIdx.x; i < (size_t)n; i += (size_t)gridDim.x * 256) out[i] = (i < lim) ? 100.0f * (float)(kf + 1) : 0.0f;
}
#ifndef DBG_LAYER
#define DBG_LAYER 0
#endif
static void dbg_pre(const Args& a, int ph, hipStream_t st) {
    float* snap = (float*)(a.ws + WS_SNAP);
    if (ph == NPHASE - 1) { hipLaunchKernelGGL(dbg_snap, dim3(DBG_NS), dim3(256), 0, st, (const float*)a.out, (const float*)(a.ws + WS_XC), snap); return; }
    if (ph < 1) return; const int l = (ph - 1) / 9, k = (ph - 1) % 9; if (l != DBG_LAYER) return;
    if (k == 5) hipLaunchKernelGGL(dbg_snap, dim3(DBG_NS), dim3(256), 0, st, l == 0 ? a.x : (const float*)a.out, l == 0 ? a.ctx : (const float*)(a.ws + WS_XC), snap);
    if (k == 8) hipLaunchKernelGGL(dbg_snap, dim3(DBG_NS), dim3(256), 0, st, (const float*)a.out, (const float*)(a.ws + WS_XC), snap);
}
static void dbg_post(const Args& a, int ph, hipStream_t st) {
    float* errb = (float*)(a.ws + WS_CTL) + CW_ERR; float* snap = (float*)(a.ws + WS_SNAP);
    if (ph == 0) { DbgP p{a, 0, 0, errb + 0}; hipLaunchKernelGGL(dbg_mod, dim3(DEPTH * 17), dim3(256), 0, st, p); return; }
    if (ph == NPHASE - 1) { DbgP p{a, 0, 0, errb + 80}; hipLaunchKernelGGL(dbg_final, dim3(DBG_NS), dim3(256), 0, st, p, (const float*)snap); return; }
    const int l = (ph - 1) / 9, k = (ph - 1) % 9; if (l != DBG_LAYER) return; const bool lastl = l == DEPTH - 1; const int mact = lastl ? MLAT : MTOT; float* e = errb + 8 * (k + 1);
    const float* xs = l == 0 ? a.x : (const float*)a.out; const float* cs = l == 0 ? a.ctx : (const float*)(a.ws + WS_XC);
    DbgP p{a, l, 0, e};
    if (k == 0) hipLaunchKernelGGL(dbg_norm, dim3(DBG_NS), dim3(256), 0, st, p, xs, cs, a.norm1_g + l * DM, 0, DM, MTOT);
    if (k == 1) hipLaunchKernelGGL(dbg_inproj, dim3(32, DBG_NS), dim3(256), 0, st, p);
    if (k == 2) hipLaunchKernelGGL(dbg_up, dim3(14, DBG_NS), dim3(256), 0, st, p);
    if (k == 3) hipLaunchKernelGGL(dbg_attn, dim3(8, DBG_NS), dim3(256), 0, st, p, lastl ? 1 : 0);
    if (k == 4) hipLaunchKernelGGL(dbg_merge, dim3(8, DBG_NS), dim3(256), 0, st, p, mact);
    if (k == 5) hipLaunchKernelGGL(dbg_resid, dim3(8, DBG_NS), dim3(256), 0, st, p, (const bf16*)(a.ws + WS_BIG + B_MG), DM, a.w_out + (size_t)l * DM * DM, 2 * DM, (const float*)snap, mact);
    if (k == 6) hipLaunchKernelGGL(dbg_norm, dim3(DBG_NS), dim3(256), 0, st, p, (const float*)a.out, (const float*)(a.ws + WS_XC), a.norm2_g + l * DM, 3 * DM, 4 * DM, mact);
    if (k == 7) hipLaunchKernelGGL(dbg_mlp1, dim3(32, DBG_NS), dim3(256), 0, st, p, mact);
    if (k == 8) hipLaunchKernelGGL(dbg_resid, dim3(8, DBG_NS), dim3(256), 0, st, p, (const bf16*)(a.ws + WS_BIG + B_U), DFF, a.w_mlp2 + (size_t)l * DFF * DM, 5 * DM, (const float*)snap, mact);
}
#endif
extern "C" void kernel_launch(void* const* d_in, const int* in_sizes, int n_in, void* d_out, int out_size, void* d_ws, size_t ws_size, hipStream_t stream) {
    static int grid = 0;
    if (grid == 0) {
        if (n_in != 22 || in_sizes[0] != MLAT * DM || out_size != MLAT * DM || ws_size < WS_END) {
            fprintf(stderr, "kernel_launch: shape mismatch (n_in %d, in0 %d, out %d, ws %zu; need ws >= %zu); nothing launched\n", n_in, n_in > 0 ? in_sizes[0] : -1, out_size, ws_size, (size_t)WS_END); grid = -1; return; }
        int dev = 0, cus = 0, per_cu = 0;
        if (hipGetDevice(&dev) != hipSuccess || hipDeviceGetAttribute(&cus, hipDeviceAttributeMultiprocessorCount, dev) != hipSuccess) { fprintf(stderr, "kernel_launch: device query failed\n"); grid = -1; return; }
        if (hipFuncSetAttribute((const void*)mk_fwd, hipFuncAttributeMaxDynamicSharedMemorySize, LDS_BYTES) != hipSuccess) { fprintf(stderr, "kernel_launch: hipFuncSetAttribute failed\n"); grid = -1; return; }
        if (hipOccupancyMaxActiveBlocksPerMultiprocessor(&per_cu, (const void*)mk_fwd, NWAVES * 64, LDS_BYTES) != hipSuccess || per_cu < 1)
            fprintf(stderr, "kernel_launch: note: occupancy query reports %d workgroups per CU\n", per_cu);
        (void)hipGetLastError();
        grid = cus;
        if (grid > 256) grid = 256;
    }
    if (grid < 0) return;
    if (hipMemsetAsync((char*)d_ws + WS_CTL, 0, CTL_ZERO_BYTES, stream) != hipSuccess) { fprintf(stderr, "kernel_launch: memset failed\n"); return; }
    Args a{};
    a.x = (const float*)d_in[0]; a.c = (const float*)d_in[1]; a.ctx = (const float*)d_in[2]; a.c_ctx = (const float*)d_in[3]; a.w_ada = (const float*)d_in[4]; a.b_ada = (const float*)d_in[5];
    a.norm1_g = (const float*)d_in[6]; a.norm2_g = (const float*)d_in[7]; a.w_in = (const float*)d_in[8]; a.b_gate = (const float*)d_in[9]; a.q_a_norm = (const float*)d_in[10];
    a.w_uq = (const float*)d_in[11]; a.kv_a_norm = (const float*)d_in[12]; a.w_ukv = (const float*)d_in[13]; a.diff_lambda = (const float*)d_in[14]; a.diff_subln = (const float*)d_in[15];
    a.w_o_diff = (const float*)d_in[16]; a.w_o_mla = (const float*)d_in[17]; a.w_out = (const float*)d_in[18]; a.w_mlp1 = (const float*)d_in[19]; a.w_mlp2 = (const float*)d_in[20];
    a.final_norm_g = (const float*)d_in[21];
    a.out = (float*)d_out; a.ws = (unsigned char*)d_ws;
#if MK_MULTI
    for (int p = 0; p < NPHASE; ++p) {
        a.ph_lo = p; a.ph_hi = p + 1;
#if MK_DEBUG
        dbg_pre(a, p, stream);
#endif
        hipLaunchKernelGGL(mk_fwd, dim3(grid), dim3(NWAVES * 64), LDS_BYTES, stream, a);
#if MK_DEBUG
        dbg_post(a, p, stream);
#endif
    }
#if MK_DEBUG
    hipLaunchKernelGGL(dbg_report, dim3(1024), dim3(256), 0, stream, (const float*)((char*)d_ws + WS_CTL) + CW_ERR, (float*)d_out, out_size);
#endif
#else
    a.ph_lo = 0; a.ph_hi = NPHASE;
    hipLaunchKernelGGL(mk_fwd, dim3(grid), dim3(NWAVES * 64), LDS_BYTES, stream, a);
#endif
    const hipError_t le = hipPeekAtLastError();
    if (le != hipSuccess) fprintf(stderr, "kernel_launch: launch failed: %s\n", hipGetErrorName(le));
}
```
